# Optimizing an MI355X kernel written in HIP

```python
import math
import jax, jax.numpy as jnp
from jax import lax
import numpy as np

D_MODEL = 1024
BATCH = 4
SEQ = 4096
DEPTH = 2

HEAD_DIM = 64
N_ATTN_HEADS = 8
ATTN_WIDTH = N_ATTN_HEADS * HEAD_DIM
LRU_WIDTH = D_MODEL - ATTN_WIDTH
N_LRU_BLOCKS = 8
LRU_BLOCK = LRU_WIDTH // N_LRU_BLOCKS
MIX_WIDTH = ATTN_WIDTH + LRU_WIDTH
IN_WIDTH = 3 * ATTN_WIDTH + 2 * LRU_WIDTH
CONV_WIDTH = 4
LRU_C = 8.0
D_FF = 4 * D_MODEL
BLOCK_Q = 128
EPS = 1e-6

kernel_name = 'hymba_style_rglru_stickbreaking_block'


def rms_norm(x, g):
    xf = x.astype(jnp.float32)
    y = xf * lax.rsqrt(jnp.mean(xf * xf, axis=-1, keepdims=True) + EPS)
    return (y * g.astype(jnp.float32)).astype(x.dtype)


def causal_depthwise_conv(u, w, b):
    S = u.shape[1]
    up = jnp.pad(u, ((0, 0), (CONV_WIDTH - 1, 0), (0, 0)))
    out = b
    for k in range(CONV_WIDTH):
        out = out + up[:, k:k + S] * w[k]
    return out


def _linear_rec_combine(left, right):
    a1, b1 = left
    a2, b2 = right
    return a1 * a2, a2 * b1 + b2


def rg_lru(u, w_rg, b_rg, w_ig, b_ig, lam):
    B, S, _ = u.shape
    ub = u.reshape(B, S, N_LRU_BLOCKS, LRU_BLOCK)
    r = jax.nn.sigmoid(jnp.einsum('bsnc,ncd->bsnd', ub, w_rg) + b_rg.reshape(N_LRU_BLOCKS, LRU_BLOCK))
    i = jax.nn.sigmoid(jnp.einsum('bsnc,ncd->bsnd', ub, w_ig) + b_ig.reshape(N_LRU_BLOCKS, LRU_BLOCK))
    r = r.reshape(B, S, LRU_WIDTH).astype(jnp.float32)
    i = i.reshape(B, S, LRU_WIDTH).astype(jnp.float32)
    log_a = -LRU_C * r * jax.nn.softplus(-lam.astype(jnp.float32))
    a = jnp.exp(log_a)
    mult = jnp.sqrt(-jnp.expm1(2.0 * log_a))
    bterm = mult * (i * u.astype(jnp.float32))
    _, h = lax.associative_scan(_linear_rec_combine, (a, bterm), axis=1)
    return h.astype(u.dtype)


def stick_breaking_attention(q, k, v):
    S = q.shape[1]
    scale = 1.0 / math.sqrt(HEAD_DIM)
    qf = q.astype(jnp.float32)
    kf = k.astype(jnp.float32)
    vf = v.astype(jnp.float32)
    outs = []
    for blk in range(S // BLOCK_Q):
        q0 = blk * BLOCK_Q
        end = q0 + BLOCK_Q
        z = jnp.einsum('bqhd,bkhd->bhqk', qf[:, q0:end], kf[:, :end]) * scale
        qpos = q0 + jnp.arange(BLOCK_Q)[:, None]
        kpos = jnp.arange(end)[None, :]
        mask = kpos < qpos
        log_one_minus = jnp.where(mask, jax.nn.log_sigmoid(-z), 0.0)
        suffix = lax.cumsum(log_one_minus, axis=3, reverse=True) - log_one_minus
        log_w = jax.nn.log_sigmoid(z) + suffix
        w = jnp.where(mask, jnp.exp(log_w), 0.0)
        outs.append(jnp.einsum('bhqk,bkhd->bqhd', w, vf[:, :end]))
    return jnp.concatenate(outs, axis=1).astype(v.dtype)


def hybrid_mixer(h, w_in, conv_w, conv_b, w_rg, b_rg, w_ig, b_ig, lam, q_norm_g, k_norm_g, w_out):
    B, S, _ = h.shape
    proj = h @ w_in
    q, k, v, xl, gl = jnp.split(proj, [ATTN_WIDTH, 2 * ATTN_WIDTH, 3 * ATTN_WIDTH, 3 * ATTN_WIDTH + LRU_WIDTH], axis=-1)
    q = rms_norm(q.reshape(B, S, N_ATTN_HEADS, HEAD_DIM), q_norm_g)
    k = rms_norm(k.reshape(B, S, N_ATTN_HEADS, HEAD_DIM), k_norm_g)
    v = v.reshape(B, S, N_ATTN_HEADS, HEAD_DIM)
    attn = stick_breaking_attention(q, k, v).reshape(B, S, ATTN_WIDTH)
    xl = causal_depthwise_conv(xl, conv_w, conv_b)
    lru = rg_lru(xl, w_rg, b_rg, w_ig, b_ig, lam) * jax.nn.gelu(gl)
    return jnp.concatenate([attn, lru], axis=-1) @ w_out


def sq_relu_mlp(h, w_up, w_down):
    return jnp.square(jax.nn.relu(h @ w_up)) @ w_down


def setup_inputs(seed: int = 0) -> dict:
    key = jax.random.key(seed)
    ks = jax.random.split(key, 17)
    f32 = jnp.float32
    nrm = lambda kk, shape, s: jax.random.normal(kk, shape, f32) * s
    a0 = jax.random.uniform(ks[10], (DEPTH, LRU_WIDTH), f32, minval=0.9, maxval=0.999)
    return {
        'x': jax.random.normal(ks[0], (BATCH, SEQ, D_MODEL), f32),
        'norm1_g': 1.0 + nrm(ks[1], (DEPTH, D_MODEL), 0.02),
        'w_in': nrm(ks[2], (DEPTH, D_MODEL, IN_WIDTH), D_MODEL ** -0.5),
        'conv_w': nrm(ks[3], (DEPTH, CONV_WIDTH, LRU_WIDTH), CONV_WIDTH ** -0.5),
        'conv_b': nrm(ks[4], (DEPTH, LRU_WIDTH), 0.01),
        'w_rg': nrm(ks[5], (DEPTH, N_LRU_BLOCKS, LRU_BLOCK, LRU_BLOCK), LRU_BLOCK ** -0.5),
        'b_rg': nrm(ks[6], (DEPTH, LRU_WIDTH), 0.01),
        'w_ig': nrm(ks[7], (DEPTH, N_LRU_BLOCKS, LRU_BLOCK, LRU_BLOCK), LRU_BLOCK ** -0.5),
        'b_ig': nrm(ks[8], (DEPTH, LRU_WIDTH), 0.01),
        'lru_lambda': jnp.log(a0) - jnp.log1p(-a0),
        'q_norm_g': 1.0 + nrm(ks[11], (DEPTH, HEAD_DIM), 0.02),
        'k_norm_g': 1.0 + nrm(ks[12], (DEPTH, HEAD_DIM), 0.02),
        'w_out': nrm(ks[13], (DEPTH, MIX_WIDTH, D_MODEL), MIX_WIDTH ** -0.5),
        'norm2_g': 1.0 + nrm(ks[14], (DEPTH, D_MODEL), 0.02),
        'w_up': nrm(ks[15], (DEPTH, D_MODEL, D_FF), D_MODEL ** -0.5),
        'w_down': nrm(ks[16], (DEPTH, D_FF, D_MODEL), D_FF ** -0.5),
    }


def reference(x, norm1_g, w_in, conv_w, conv_b, w_rg, b_rg, w_ig, b_ig, lru_lambda, q_norm_g, k_norm_g, w_out, norm2_g, w_up, w_down):
    for l in range(DEPTH):
        h = rms_norm(x, norm1_g[l])
        x = x + hybrid_mixer(h, w_in[l], conv_w[l], conv_b[l], w_rg[l], b_rg[l], w_ig[l], b_ig[l],
                             lru_lambda[l], q_norm_g[l], k_norm_g[l], w_out[l])
        h = rms_norm(x, norm2_g[l])
        x = x + sq_relu_mlp(h, w_up[l], w_down[l])
    return x
```

```cpp
#include <hip/hip_runtime.h>
#include <hip/hip_cooperative_groups.h>
#include <cstdio>
#include <cstdint>
namespace cg = cooperative_groups;
namespace pg8 {
#define PG8_LAS __attribute__((address_space(3)))
typedef unsigned short bf16_t;
typedef short bf16x8 __attribute__((ext_vector_type(8)));
typedef float f32x4 __attribute__((ext_vector_type(4)));
typedef unsigned u32x4 __attribute__((ext_vector_type(4)));
constexpr int BM = 256, BK = 64, HALF = 128, HTB = HALF * BK * 2  , STAGE_BYTES = 8 * HTB, NXCD = 8, WGM = 8;

__host__ __device__ __forceinline__ int lds_byte(int r, int c) { const int st = (r >> 4) * 2 + (c >> 5), rr = r & 15, cc = c & 31, ob = rr * 64 + cc * 2; return st * 1024 + (ob ^ (((ob >> 9) & 1) << 5)); }
__host__ __device__ __forceinline__ void stage_rc(int b, int& R, int& C) { const int st = b / 1024, sb = b % 1024, swz = sb ^ (((sb >> 9) & 1) << 5); R = (st >> 1) * 16 + swz / 64; C = (st & 1) * 32 + (swz % 64) / 2; }
__host__ __device__ __forceinline__ int perm32(int rho) { const int n = rho >> 4, i = rho & 15; return 8 * (i >> 2) + 4 * n + (i & 3); }

struct Unit { int pm, pn; };
struct Gemm { const bf16_t* A; const bf16_t* Bt; int M, N, K; };

struct StaticOrder {
    int nM, nN, nwg, G, c;
    __host__ __device__ void init(int M, int N, int G_, int c_) { nM = M / BM; nN = N / BM; nwg = nM * nN; G = G_; c = c_; }
    __host__ __device__ bool next(int i, Unit& u) const {
        const long L = (long)i * G + c; if (L >= nwg) return false;
        int wgid = (int)L; { const int q = nwg / NXCD, r = nwg % NXCD, xcd = wgid % NXCD, off = wgid / NXCD; wgid = (xcd < r ? xcd * (q + 1) : r * (q + 1) + (xcd - r) * q) + off; }
        const int nig = WGM * nN, gid = wgid / nig, fm = gid * WGM, gsz = (nM - fm) < WGM ? (nM - fm) : WGM;
        u.pm = fm + ((wgid % nig) % gsz); u.pn = (wgid % nig) / gsz; return true;
    }
    __device__ __forceinline__ void a_ready(const Unit&) const {}
    __device__ __forceinline__ void done(const Unit&) const {}
};

__device__ __forceinline__ unsigned cvt_pk_bf16(float lo, float hi) { unsigned r; asm volatile("v_cvt_pk_bf16_f32 %0, %1, %2" : "=v"(r) : "v"(lo), "v"(hi)); return r; }
__device__ __forceinline__ float lane_xor32(float v) { const auto r = __builtin_amdgcn_permlane32_swap(__float_as_uint(v), __float_as_uint(v), false, false); return __uint_as_float((threadIdx.x & 32) ? r[0] : r[1]); }
__device__ __forceinline__ float lane_xor16(float v) { const auto r = __builtin_amdgcn_permlane16_swap(__float_as_uint(v), __float_as_uint(v), false, false); return __uint_as_float((threadIdx.x & 16) ? r[0] : r[1]); }
constexpr float RMS_EPS = 1e-6f;
template <int ACT> struct EpiScaleBf16 {
    static constexpr bool PERM = true, AFTER_DRAIN = false;
    bf16_t* O; int ldc; const float* ssq;
    __device__ __forceinline__ void operator()(const f32x4 (&acc)[2][2][4][2], const Unit& u, int wr, int wc, int fr, int fq) const {
        const int row0 = u.pm * BM + wr * 64 + fr; const int col0 = u.pn * BM + wc * 32 + 8 * fq;
#pragma unroll
        for (int ai = 0; ai < 2; ++ai)
#pragma unroll
            for (int m = 0; m < 4; ++m) { const int row = row0 + ai * HALF + m * 16;
                const f32x4 sv = *(const f32x4*)(ssq + (size_t)row * 16 + 4 * fq); float s = (sv[0] + sv[1]) + (sv[2] + sv[3]);
                s += lane_xor16(s); s += lane_xor32(s);
                const float rs = __builtin_amdgcn_rsqf(s * (1.0f / 1024.0f) + RMS_EPS);
                bf16_t* rowp = O + (size_t)row * ldc + col0;
#pragma unroll
                for (int bj = 0; bj < 2; ++bj) { f32x4 v0 = acc[ai][bj][m][0] * rs, v1 = acc[ai][bj][m][1] * rs;
                    if (ACT == 1) {
#pragma unroll
                        for (int e = 0; e < 4; ++e) { const float a = fmaxf(v0[e], 0.f), b = fmaxf(v1[e], 0.f); v0[e] = a * a; v1[e] = b * b; } }
                    u32x4 w; w.x = cvt_pk_bf16(v0[0], v0[1]); w.y = cvt_pk_bf16(v0[2], v0[3]); w.z = cvt_pk_bf16(v1[0], v1[1]); w.w = cvt_pk_bf16(v1[2], v1[3]);
                    *(u32x4*)(rowp + bj * HALF) = w; } }
    }
};
template <bool BASE_F32, bool OUT_F32, bool USE_LO> struct EpiResid {
    static constexpr bool PERM = false, AFTER_DRAIN = false;
    const float* base_f; const bf16_t* base_hi; const bf16_t* base_lo; float* out_f; bf16_t* out_hi; bf16_t* out_lo; float* ssq_out; float accs;
    __device__ __forceinline__ void operator()(const f32x4 (&acc)[2][2][4][2], const Unit& u, int wr, int wc, int fr, int fq) const {
        typedef unsigned u32x2v __attribute__((ext_vector_type(2)));
        const int col0 = u.pn * BM + wc * 32 + 4 * fq;
#pragma unroll
        for (int ai = 0; ai < 2; ++ai) {
            f32x4 pre[4][2][2]; u32x2v ph[4][2][2], pl[4][2][2];
#pragma unroll
            for (int m = 0; m < 4; ++m) { const size_t off = (size_t)(u.pm * BM + ai * HALF + wr * 64 + m * 16 + fr) * 1024 + col0;
#pragma unroll
                for (int bj = 0; bj < 2; ++bj)
#pragma unroll
                    for (int n = 0; n < 2; ++n) {
                        if (BASE_F32) pre[m][bj][n] = *(const f32x4*)(base_f + off + bj * HALF + n * 16);
                        else { ph[m][bj][n] = *(const u32x2v*)(base_hi + off + bj * HALF + n * 16); if (USE_LO) pl[m][bj][n] = *(const u32x2v*)(base_lo + off + bj * HALF + n * 16); } } }
#pragma unroll
            for (int m = 0; m < 4; ++m) { const int r = u.pm * BM + ai * HALF + wr * 64 + m * 16 + fr; const size_t off = (size_t)r * 1024 + col0; float s = 0.f;
#pragma unroll
                for (int bj = 0; bj < 2; ++bj)
#pragma unroll
                    for (int n = 0; n < 2; ++n) { f32x4 bs;
                        if (BASE_F32) bs = pre[m][bj][n];
                        else { const u32x2v h = ph[m][bj][n]; u32x2v l = {0u, 0u}; if (USE_LO) l = pl[m][bj][n];
                            bs[0] = __uint_as_float(h.x << 16) + __uint_as_float(l.x << 16); bs[1] = __uint_as_float(h.x & 0xffff0000u) + __uint_as_float(l.x & 0xffff0000u);
                            bs[2] = __uint_as_float(h.y << 16) + __uint_as_float(l.y << 16); bs[3] = __uint_as_float(h.y & 0xffff0000u) + __uint_as_float(l.y & 0xffff0000u); }
                        const f32x4 o = bs + acc[ai][bj][m][n] * accs;
                        if (OUT_F32) *(f32x4*)(out_f + off + bj * HALF + n * 16) = o;
                        else { s += (o[0] * o[0] + o[1] * o[1]) + (o[2] * o[2] + o[3] * o[3]);
                            u32x2v w; w.x = cvt_pk_bf16(o[0], o[1]); w.y = cvt_pk_bf16(o[2], o[3]); *(u32x2v*)(out_hi + off + bj * HALF + n * 16) = w;
                            if (USE_LO) { u32x2v e; e.x = cvt_pk_bf16(o[0] - __uint_as_float(w.x << 16), o[1] - __uint_as_float(w.x & 0xffff0000u));
                            e.y = cvt_pk_bf16(o[2] - __uint_as_float(w.y << 16), o[3] - __uint_as_float(w.y & 0xffff0000u)); *(u32x2v*)(out_lo + off + bj * HALF + n * 16) = e; } } }
                if (!OUT_F32) { s += lane_xor16(s); s += lane_xor32(s);
                    if (fq == 0) ssq_out[(size_t)r * 16 + u.pn * 4 + wc] = s; } }
            asm volatile("" ::: "memory");
        }
    }
};
template <class Epi, class Sched, bool ALIGN_EPI = false, bool SP2 = false>
__device__ __forceinline__ void gemm_phase(PG8_LAS unsigned char* lds, const Gemm g, const Sched& S, const Epi& E) {
    int tid_ = threadIdx.x; asm volatile("" : "+v"(tid_));
    const int tid = tid_, wid = __builtin_amdgcn_readfirstlane(tid >> 6), lane = tid & 63, wr = wid >> 2, wc = wid & 3, fr = lane & 15, fq = lane >> 4;
    const int K = g.K, nt = K / BK;
    unsigned voffA[2], voffB[2];
#pragma unroll
    for (int i = 0; i < 2; ++i) { int R, C; stage_rc(tid * 16 + i * 8192, R, C); const int Rb = Epi::PERM ? ((R & ~31) + perm32(R & 31)) : R;
        voffA[i] = (unsigned)(R * K + C) * 2u; voffB[i] = (unsigned)(Rb * K + C) * 2u; }
    const size_t kstep = (size_t)(BK * 2);
    const size_t hstep = (size_t)HALF * K * 2;
    const size_t tstep = 2 * hstep;
    const unsigned ldsw = (unsigned)wid * 1024u;
    const int aoff = lds_byte(wr * 64 + fr, fq * 8), boff = lds_byte(wc * 32 + fr, fq * 8);
#define PG8_SA(b, h) (((b) * 2 + (h)) * HTB)
#define PG8_SB(b, h) ((4 + (b) * 2 + (h)) * HTB)
#define PG8_STAGE(bufoff, gbase, voff) do { _Pragma("unroll") for (int _i = 0; _i < 2; ++_i) \
        __builtin_amdgcn_global_load_lds((const unsigned*)((const char*)(gbase) + (voff)[_i]), (PG8_LAS unsigned*)(lds + (bufoff) + ldsw + _i * 8192), 16, 0, 0); } while (0)
#define PG8_LDA(dst, b, h) do { _Pragma("unroll") for (int m = 0; m < 4; ++m) _Pragma("unroll") for (int k = 0; k < 2; ++k) dst[m][k] = *(const PG8_LAS bf16x8*)(lds + PG8_SA(b, h) + aoff + m * 2048 + k * 1024); } while (0)
#define PG8_LDB(dst, b, h) do { _Pragma("unroll") for (int n = 0; n < 2; ++n) _Pragma("unroll") for (int k = 0; k < 2; ++k) dst[n][k] = *(const PG8_LAS bf16x8*)(lds + PG8_SB(b, h) + boff + n * 2048 + k * 1024); } while (0)
#define PG8_MMA(ai, bj, At, Bt) do { __builtin_amdgcn_s_setprio(1); _Pragma("unroll") for (int m = 0; m < 4; ++m) _Pragma("unroll") for (int n = 0; n < 2; ++n) _Pragma("unroll") for (int k = 0; k < 2; ++k) \
        acc[ai][bj][m][n] = __builtin_amdgcn_mfma_f32_16x16x32_bf16(Bt[n][k], At[m][k], acc[ai][bj][m][n], 0, 0, 0); __builtin_amdgcn_s_setprio(0); } while (0)
#define PG8_WAIT_V(n) asm volatile("s_waitcnt vmcnt(" #n ")" ::: "memory")
#define PG8_WAIT_L(n) asm volatile("s_waitcnt lgkmcnt(" #n ")" ::: "memory")
#define PG8_BAR __builtin_amdgcn_s_barrier()
#define PG8_SCHED __builtin_amdgcn_sched_barrier(0)
    Unit cur, nxt; int ui = 0;
    if (!S.next(0, cur)) return;
    f32x4 acc[2][2][4][2];
#pragma unroll
    for (int a = 0; a < 2; ++a)
#pragma unroll
        for (int b = 0; b < 2; ++b)
#pragma unroll
            for (int m = 0; m < 4; ++m)
#pragma unroll
                for (int n = 0; n < 2; ++n) acc[a][b][m][n] = (f32x4){0.f, 0.f, 0.f, 0.f};
    bf16x8 At[4][2], B0[2][2], B1[2][2];
    const char* cA = (const char*)g.A + (size_t)cur.pm * tstep; const char* cB = (const char*)g.Bt + (size_t)cur.pn * tstep;
    S.a_ready(cur);
    if constexpr (SP2) {
        PG8_STAGE(PG8_SB(0, 0), cB, voffB); PG8_STAGE(PG8_SB(0, 1), cB + hstep, voffB); PG8_STAGE(PG8_SA(0, 0), cA, voffA); PG8_STAGE(PG8_SA(0, 1), cA + hstep, voffA);
        if (wr == 1) PG8_BAR;
        PG8_WAIT_V(2); PG8_BAR;
        PG8_STAGE(PG8_SB(1, 0), cB + kstep, voffB); PG8_STAGE(PG8_SA(1, 0), cA + kstep, voffA); PG8_STAGE(PG8_SB(1, 1), cB + hstep + kstep, voffB);
        PG8_WAIT_V(6); PG8_BAR;
    } else {
        PG8_STAGE(PG8_SB(0, 0), cB, voffB); PG8_STAGE(PG8_SA(0, 0), cA, voffA); PG8_STAGE(PG8_SB(0, 1), cB + hstep, voffB); PG8_STAGE(PG8_SA(0, 1), cA + hstep, voffA);
        if (wr == 1) PG8_BAR;
        PG8_WAIT_V(4); PG8_BAR;
        PG8_STAGE(PG8_SB(1, 0), cB + kstep, voffB); PG8_STAGE(PG8_SA(1, 0), cA + kstep, voffA); PG8_STAGE(PG8_SB(1, 1), cB + hstep + kstep, voffB);
        PG8_WAIT_V(6); PG8_BAR;
    }
    for (;;) {
        const bool has_next = S.next(ui + 1, nxt);
        const char* nA = has_next ? (const char*)g.A + (size_t)nxt.pm * tstep : cA; const char* nB = has_next ? (const char*)g.Bt + (size_t)nxt.pn * tstep : cB;
        for (int t = 0; t < nt; t += 2) {
            const bool last = (t == nt - 2);
            const char* a1 = cA + (size_t)(t + 1) * kstep;
            const char* a2 = last ? nA : cA + (size_t)(t + 2) * kstep; const char* b2 = last ? nB : cB + (size_t)(t + 2) * kstep;
            const char* a3 = a2 + kstep; const char* b3 = b2 + kstep;
            if (last && has_next) S.a_ready(nxt);
            if constexpr (SP2) {
            PG8_LDB(B0, 0, 0); PG8_LDB(B1, 0, 1); PG8_SCHED; PG8_LDA(At, 0, 0); PG8_STAGE(PG8_SA(1, 1), a1 + hstep, voffA);
            PG8_WAIT_V(8); PG8_WAIT_L(0); PG8_BAR; PG8_MMA(0, 0, At, B0); PG8_MMA(0, 1, At, B1); PG8_BAR; PG8_SCHED;
            PG8_LDA(At, 0, 1); PG8_STAGE(PG8_SB(0, 0), b2, voffB); PG8_STAGE(PG8_SB(0, 1), b2 + hstep, voffB); PG8_STAGE(PG8_SA(0, 0), a2, voffA);
            PG8_WAIT_V(8); PG8_WAIT_L(0); PG8_BAR; PG8_MMA(1, 0, At, B0); PG8_MMA(1, 1, At, B1); PG8_BAR; PG8_SCHED;
            PG8_LDB(B0, 1, 0); PG8_LDB(B1, 1, 1); PG8_SCHED; PG8_LDA(At, 1, 0); PG8_STAGE(PG8_SA(0, 1), a2 + hstep, voffA);
            PG8_WAIT_V(8); PG8_WAIT_L(0); PG8_BAR; PG8_MMA(0, 0, At, B0); PG8_MMA(0, 1, At, B1); PG8_BAR; PG8_SCHED;
            PG8_LDA(At, 1, 1); PG8_STAGE(PG8_SB(1, 0), b3, voffB); PG8_STAGE(PG8_SB(1, 1), b3 + hstep, voffB); PG8_STAGE(PG8_SA(1, 0), a3, voffA);
            PG8_WAIT_V(8); PG8_WAIT_L(0); PG8_BAR; PG8_MMA(1, 0, At, B0); PG8_MMA(1, 1, At, B1); PG8_BAR; PG8_SCHED;
            } else {
            PG8_LDB(B0, 0, 0); PG8_SCHED; PG8_LDA(At, 0, 0); PG8_STAGE(PG8_SA(1, 1), a1 + hstep, voffA);
            PG8_WAIT_L(8); PG8_BAR; PG8_WAIT_L(0); PG8_MMA(0, 0, At, B0); PG8_BAR; PG8_SCHED;
            PG8_LDB(B1, 0, 1); PG8_STAGE(PG8_SB(0, 0), b2, voffB);
            PG8_BAR; PG8_WAIT_L(0); PG8_MMA(0, 1, At, B1); PG8_BAR;
            PG8_LDA(At, 0, 1); PG8_STAGE(PG8_SA(0, 0), a2, voffA);
            PG8_BAR; PG8_WAIT_L(0); PG8_MMA(1, 0, At, B0); PG8_BAR; PG8_SCHED;
            PG8_STAGE(PG8_SB(0, 1), b2 + hstep, voffB);
            PG8_WAIT_V(6); PG8_BAR; PG8_MMA(1, 1, At, B1); PG8_BAR;
            PG8_LDB(B0, 1, 0); PG8_SCHED; PG8_LDA(At, 1, 0); PG8_STAGE(PG8_SA(0, 1), a2 + hstep, voffA);
            PG8_WAIT_L(8); PG8_BAR; PG8_WAIT_L(0); PG8_MMA(0, 0, At, B0); PG8_BAR; PG8_SCHED;
            PG8_LDB(B1, 1, 1); PG8_STAGE(PG8_SB(1, 0), b3, voffB);
            PG8_BAR; PG8_WAIT_L(0); PG8_MMA(0, 1, At, B1); PG8_BAR;
            PG8_LDA(At, 1, 1); PG8_STAGE(PG8_SA(1, 0), a3, voffA);
            PG8_BAR; PG8_WAIT_L(0); PG8_MMA(1, 0, At, B0); PG8_BAR; PG8_SCHED;
            PG8_STAGE(PG8_SB(1, 1), b3 + hstep, voffB);
            PG8_WAIT_V(6); PG8_BAR; PG8_MMA(1, 1, At, B1); PG8_BAR;
            }
        }
        if constexpr (ALIGN_EPI) { if (wr == 0) PG8_BAR; }
        if constexpr (!Epi::AFTER_DRAIN) { E(acc, cur, wr, wc, fr, fq); S.done(cur); }
        if (!has_next) break;
#pragma unroll
        for (int a = 0; a < 2; ++a)
#pragma unroll
            for (int b = 0; b < 2; ++b)
#pragma unroll
                for (int m = 0; m < 4; ++m)
#pragma unroll
                    for (int n = 0; n < 2; ++n) acc[a][b][m][n] = (f32x4){0.f, 0.f, 0.f, 0.f};
        cur = nxt; cA = nA; cB = nB; ++ui;
        if constexpr (ALIGN_EPI) { if (wr == 1) PG8_BAR; }
    }
    PG8_WAIT_V(0);
    if constexpr (!ALIGN_EPI) { if (wr == 0) PG8_BAR; }
    PG8_BAR;
    if constexpr (Epi::AFTER_DRAIN) { E.fused(acc, cur, wr, wc, fr, fq, lds, wid, lane); S.done(cur); }
#undef PG8_SA
#undef PG8_SB
#undef PG8_STAGE
#undef PG8_LDA
#undef PG8_LDB
#undef PG8_MMA
#undef PG8_WAIT_V
#undef PG8_WAIT_L
#undef PG8_BAR
#undef PG8_SCHED
}
}

constexpr int BATCH = 4, SEQ = 4096, DM = 1024, DEPTH = 2, HD = 64, NH = 8, AW = 512, LW = 512, NLB = 8, INW = 2560, FF = 4096;
constexpr int M = BATCH * SEQ;
constexpr int NWAVES = 8;
constexpr float LOG2E = 1.4426950408889634f, LN2 = 0.6931471805599453f, RMS_EPS = pg8::RMS_EPS;
constexpr int LCH = 64, NCH = SEQ / LCH;
#define LAS __attribute__((address_space(3)))
typedef unsigned short bf16;
typedef unsigned u32x4 __attribute__((ext_vector_type(4)));
typedef unsigned u32x2 __attribute__((ext_vector_type(2)));
typedef float f32x4 __attribute__((ext_vector_type(4)));
typedef float f32x2 __attribute__((ext_vector_type(2)));
typedef float f32x16 __attribute__((ext_vector_type(16)));
typedef short bf16x8 __attribute__((ext_vector_type(8)));
typedef __bf16 bf16x2_t __attribute__((ext_vector_type(2)));

constexpr size_t MiB = 1u << 20;
constexpr size_t WS_SSQA = 0, WS_SSQB = 1 * MiB, WS_SUMM = 2 * MiB, WS_GATE = 3 * MiB, WS_W = 4 * MiB;
constexpr size_t W_IN_OFF = 0, W_OUT_OFF = 5 * MiB, W_UP_OFF = 7 * MiB, W_DOWN_OFF = 15 * MiB, W_LAYER = 23 * MiB;
constexpr size_t WS_BAR = 3 * MiB + 512 * 1024;
constexpr size_t WS_XB = 50 * MiB, WS_H = 82 * MiB, WS_PROJ = 82 * MiB, WS_MIX = 162 * MiB, WS_AB = 210 * MiB, WS_LO1 = 210 * MiB, WS_END = 242 * MiB;
constexpr int LRU_WAVE_LDS = 16896;
constexpr int LDS_MISC = 8 * LRU_WAVE_LDS, LDS_BYTES = LDS_MISC + 1024;

__device__ __forceinline__ unsigned pk_bf16(float lo, float hi) { f32x2 v = {lo, hi}; bf16x2_t b = __builtin_convertvector(v, bf16x2_t); return __builtin_bit_cast(unsigned, b); }
__device__ __forceinline__ float bf_lo(unsigned u) { return __uint_as_float(u << 16); }
__device__ __forceinline__ float bf_hi(unsigned u) { return __uint_as_float(u & 0xffff0000u); }
__device__ __forceinline__ float bf2f(bf16 h) { return __uint_as_float((unsigned)h << 16); }
__device__ __forceinline__ float xhalf(float v) {
    const auto r = __builtin_amdgcn_permlane32_swap(__float_as_uint(v), __float_as_uint(v), false, false);
    return __uint_as_float((threadIdx.x & 32) ? r[0] : r[1]);
}
__device__ __forceinline__ float wave_sum(float v) {
#pragma unroll
    for (int o = 1; o < 64; o <<= 1) v += __shfl_xor(v, o);
    return v;
}
#define LDS_WAIT() asm volatile("s_waitcnt lgkmcnt(0)" ::: "memory")

struct In { const float *x, *norm1_g, *w_in, *conv_w, *conv_b, *w_rg, *b_rg, *w_ig, *b_ig, *lam, *qg, *kg, *w_out, *norm2_g, *w_up, *w_down; };
struct TItem { const float* W; const float* g; bf16* WT; int K, N, item; };
constexpr int I_IN = (DM / 64) * (INW / 32), I_OUT = (DM / 64) * (DM / 32), I_UP = (DM / 64) * (FF / 32), I_DN = (FF / 64) * (DM / 32), I_G = 2 * NLB * 2;
constexpr int I_LAYERW = I_IN + I_OUT + I_UP + I_DN;
__device__ __forceinline__ TItem resolve_w(const In& I, unsigned char* ws, int l, int r) {
    unsigned char* wb = ws + WS_W + (size_t)l * W_LAYER; TItem t;
    if (r < I_IN) { t.W = I.w_in + (size_t)l * DM * INW; t.g = I.norm1_g + l * DM; t.WT = (bf16*)(wb + W_IN_OFF); t.K = DM; t.N = INW; t.item = r; return t; } r -= I_IN;
    if (r < I_OUT) { t.W = I.w_out + (size_t)l * DM * DM; t.g = nullptr; t.WT = (bf16*)(wb + W_OUT_OFF); t.K = DM; t.N = DM; t.item = r; return t; } r -= I_OUT;
    if (r < I_UP) { t.W = I.w_up + (size_t)l * DM * FF; t.g = I.norm2_g + l * DM; t.WT = (bf16*)(wb + W_UP_OFF); t.K = DM; t.N = FF; t.item = r; return t; } r -= I_UP;
    t.W = I.w_down + (size_t)l * FF * DM; t.g = nullptr; t.WT = (bf16*)(wb + W_DOWN_OFF); t.K = FF; t.N = DM; t.item = r; return t;
}
__device__ __forceinline__ TItem resolve_gate(const In& I, unsigned char* ws, int r) {
    const int l = r / I_G, q = r % I_G, mat = q >> 1, gate = mat / NLB, nb = mat % NLB; TItem t;
    t.W = (gate ? I.w_ig : I.w_rg) + ((size_t)l * NLB + nb) * 4096; t.g = nullptr; t.WT = (bf16*)(ws + WS_GATE) + ((size_t)(l * 2 + gate) * NLB + nb) * 4096; t.K = 64; t.N = 64; t.item = q & 1; return t;
}
__device__ __forceinline__ void titem_load(const TItem& t, int lane, float (&v)[32]) {
    const int nblk = t.N / 32, kb = t.item / nblk, nb = t.item % nblk, k0 = 64 * kb, n0 = 32 * nb;
    const float* src = t.W + (size_t)(k0 + (lane >> 5)) * t.N + n0 + (lane & 31);
#pragma unroll
    for (int i = 0; i < 32; ++i) v[i] = src[(size_t)(2 * i) * t.N];
}
__device__ __forceinline__ void titem_finish(const TItem& t, LAS float* scr, int lane, const float (&v)[32]) {
    const int nblk = t.N / 32, kb = t.item / nblk, nb = t.item % nblk, k0 = 64 * kb, n0 = 32 * nb;
#pragma unroll
    for (int i = 0; i < 32; ++i) { const int kk = 2 * i + (lane >> 5); const float gv = t.g ? t.g[k0 + kk] : 1.0f; scr[kk * 33 + (lane & 31)] = v[i] * gv; }
    LDS_WAIT();
    const int c = lane & 7;
#pragma unroll
    for (int j = 0; j < 4; ++j) { const int n = (lane >> 3) + 8 * j; const LAS float* s = scr + (8 * c) * 33 + n;
        u32x4 o; o.x = pk_bf16(s[0 * 33], s[1 * 33]); o.y = pk_bf16(s[2 * 33], s[3 * 33]); o.z = pk_bf16(s[4 * 33], s[5 * 33]); o.w = pk_bf16(s[6 * 33], s[7 * 33]);
        *(u32x4*)(t.WT + (size_t)(n0 + n) * t.K + k0 + 8 * c) = o; }
    LDS_WAIT();
}
__device__ __forceinline__ void convert_w_range(const In& I, unsigned char* ws, LAS float* scr, int l, int lo, int hi, int w, int NW, int lane) {
    int it = lo + w; if (it >= hi) return;
    TItem cur = resolve_w(I, ws, l, it); float va[32]; titem_load(cur, lane, va);
    for (;;) {
        const int nx = it + NW; const bool more = nx < hi;
        TItem nxt = cur; float vb[32];
        if (more) { nxt = resolve_w(I, ws, l, nx); titem_load(nxt, lane, vb); }
        titem_finish(cur, scr, lane, va);
        if (!more) break;
        cur = nxt; it = nx;
#pragma unroll
        for (int i = 0; i < 32; ++i) va[i] = vb[i];
    }
}

__device__ __forceinline__ void p0_prologue(const In& I, unsigned char* ws, LAS unsigned char* lds, int gw, int NGW, int wave, int lane) {
    LAS float* scr = (LAS float*)(lds + wave * LRU_WAVE_LDS);
    bf16* XB = (bf16*)(ws + WS_XB); float* SSQ = (float*)(ws + WS_SSQA);
    for (int m = 2 * gw; m < M; m += 2 * NGW) {
        f32x4 v[2][4];
#pragma unroll
        for (int r = 0; r < 2; ++r)
#pragma unroll
            for (int j = 0; j < 4; ++j) v[r][j] = ((const f32x4*)(I.x + (size_t)(m + r) * DM) + lane)[64 * j];
#pragma unroll
        for (int r = 0; r < 2; ++r) { float s = 0.f; unsigned long long* o8 = (unsigned long long*)(XB + (size_t)(m + r) * DM) + lane;
#pragma unroll
            for (int j = 0; j < 4; ++j) { const f32x4 x = v[r][j]; s += (x[0] * x[0] + x[1] * x[1]) + (x[2] * x[2] + x[3] * x[3]);
                o8[64 * j] = (unsigned long long)pk_bf16(x[0], x[1]) | ((unsigned long long)pk_bf16(x[2], x[3]) << 32); }
            s = wave_sum(s);
            if (lane < 16) SSQ[(size_t)(m + r) * 16 + lane] = lane == 0 ? s : 0.f; }
    }
    convert_w_range(I, ws, scr, 0, 0, I_IN, gw, NGW, lane);
    for (int r = gw; r < DEPTH * I_G; r += NGW) { const TItem t = resolve_gate(I, ws, r); float v[32]; titem_load(t, lane, v); titem_finish(t, scr, lane, v); }
}

struct LruW { const float *conv_w, *conv_b, *b_rg, *b_ig, *lam; const bf16 *wrgT, *wigT; };
__device__ __forceinline__ float sigmoidf_(float x) { return __builtin_amdgcn_rcpf(1.0f + __builtin_amdgcn_exp2f(-x * LOG2E)); }
template <bool PASS_B>
__device__ __forceinline__ void lru_unit(LAS unsigned char* wl, const bf16* PROJ, bf16* MIX, f32x2* SUMM, unsigned* ABbuf, const LruW& w, int b, int j, int n, int lane) {
    const int l32 = lane & 31, hi = lane >> 5;
    LAS float* pre = (LAS float*)wl; LAS bf16* xcb = (LAS bf16*)wl; LAS bf16* xlt = (LAS bf16*)(wl + 8192); LAS bf16* glt = (LAS bf16*)(wl + 12800);
    bf16x8 br[2][4], bi[2][4];
    { const bf16* WR = w.wrgT + n * 4096; const bf16* WI = w.wigT + n * 4096;
#pragma unroll
      for (int nt = 0; nt < 2; ++nt)
#pragma unroll
        for (int ks = 0; ks < 4; ++ks) { br[nt][ks] = *(const bf16x8*)(WR + (32 * nt + l32) * 64 + 16 * ks + 8 * hi); bi[nt][ks] = *(const bf16x8*)(WI + (32 * nt + l32) * 64 + 16 * ks + 8 * hi); } }
    const int c = 64 * n + lane;
    unsigned* AB = ABbuf + (size_t)b * SEQ * LW + c;
    const float cw0 = w.conv_w[0 * LW + c], cw1 = w.conv_w[1 * LW + c], cw2 = w.conv_w[2 * LW + c], cw3 = w.conv_w[3 * LW + c], cb = w.conv_b[c];
    const float brg = w.b_rg[c], big = w.b_ig[c];
    float spl; { const float nl = -w.lam[c]; spl = fmaxf(nl, 0.f) + log1pf(__expf(-fabsf(nl))); }
    const float cA = -8.0f * spl * LOG2E, nbrg = -brg * LOG2E, nbig = -big * LOG2E;
    constexpr float GELU_K = -2.0f * LOG2E * 0.7978845608028654f;
    float h = 0.f, P = 1.f;
    if (PASS_B) {
        const f32x2* sp = SUMM + (size_t)b * NCH * LW + c; int jj = 0;
        for (; jj + 8 <= j; jj += 8) { f32x2 sv[8];
#pragma unroll
            for (int q = 0; q < 8; ++q) sv[q] = sp[(size_t)(jj + q) * LW];
#pragma unroll
            for (int q = 0; q < 8; ++q) h = sv[q][0] * h + sv[q][1]; }
        for (; jj < j; ++jj) { const f32x2 sv = sp[(size_t)jj * LW]; h = sv[0] * h + sv[1]; }
    }
    const int s0 = j * LCH;
    const bf16* prow = PROJ + (size_t)b * SEQ * INW;
    const int lr = lane >> 3, lc = lane & 7;
    u32x4 xnext[5];
#pragma unroll
    for (int i = 0; i < 5; ++i) { const int tr = 8 * i + lr; const int sx = s0 - 3 + tr; xnext[i] = (u32x4){0u, 0u, 0u, 0u};
        if (tr < 35 && sx >= 0) xnext[i] = *(const u32x4*)(prow + (size_t)sx * INW + 3 * AW + 64 * n + 8 * lc); }
    for (int tt = 0; tt < LCH / 32; ++tt) {
        const int st = s0 + 32 * tt;
        { u32x4 xr[5]; u32x4 gr[4];
#pragma unroll
          for (int i = 0; i < 5; ++i) xr[i] = xnext[i];
          if (PASS_B) {
#pragma unroll
              for (int i = 0; i < 4; ++i) gr[i] = *(const u32x4*)(prow + (size_t)(st + 8 * i + lr) * INW + 3 * AW + LW + 64 * n + 8 * lc); }
#pragma unroll
          for (int i = 0; i < 5; ++i) { const int tr = 8 * i + lr; if (tr < 35) *(LAS u32x4*)(xlt + tr * 64 + 8 * lc) = xr[i]; }
          if (PASS_B) {
#pragma unroll
              for (int i = 0; i < 4; ++i) *(LAS u32x4*)(glt + (8 * i + lr) * 64 + 8 * lc) = gr[i]; }
        }
        LDS_WAIT();
        float xcv[32];
        { float a3 = bf2f(xlt[0 * 64 + lane]), a2 = bf2f(xlt[1 * 64 + lane]), a1 = bf2f(xlt[2 * 64 + lane]);
#pragma unroll
          for (int t = 0; t < 32; ++t) { const float xv = bf2f(xlt[(t + 3) * 64 + lane]); xcv[t] = cb + cw0 * a3 + cw1 * a2 + cw2 * a1 + cw3 * xv; a3 = a2; a2 = a1; a1 = xv;
              xcb[t * 72 + lane] = (bf16)(pk_bf16(xcv[t], 0.f) & 0xffffu); if ((t & 7) == 7) asm volatile("" ::: "memory"); } }
        LDS_WAIT();
        bf16x8 af[4];
#pragma unroll
        for (int ks = 0; ks < 4; ++ks) af[ks] = *(const LAS bf16x8*)(xcb + l32 * 72 + 16 * ks + 8 * hi);
        LDS_WAIT();
        f32x16 pr0, pr1, pi0, pi1;
        { f32x16 ar[2], ai[2];
#pragma unroll
          for (int nt = 0; nt < 2; ++nt) {
#pragma unroll
            for (int e = 0; e < 16; ++e) { ar[nt][e] = 0.f; ai[nt][e] = 0.f; }
#pragma unroll
            for (int ks = 0; ks < 4; ++ks) { ar[nt] = __builtin_amdgcn_mfma_f32_32x32x16_bf16(af[ks], br[nt][ks], ar[nt], 0, 0, 0); ai[nt] = __builtin_amdgcn_mfma_f32_32x32x16_bf16(af[ks], bi[nt][ks], ai[nt], 0, 0, 0); } }
#pragma unroll
          for (int e = 0; e < 16; ++e) {
              const auto sr = __builtin_amdgcn_permlane32_swap(__float_as_uint(ar[0][e]), __float_as_uint(ar[1][e]), false, false);
              pr0[e] = __uint_as_float(sr[0]); pr1[e] = __uint_as_float(sr[1]);
              const auto si = __builtin_amdgcn_permlane32_swap(__float_as_uint(ai[0][e]), __float_as_uint(ai[1][e]), false, false);
              pi0[e] = __uint_as_float(si[0]); pi1[e] = __uint_as_float(si[1]); } }
        if (tt + 1 < LCH / 32) {
#pragma unroll
            for (int i = 0; i < 5; ++i) { const int tr = 8 * i + lr; const int sx = st + 32 - 3 + tr; xnext[i] = (u32x4){0u, 0u, 0u, 0u};
                if (tr < 35 && sx >= 0) xnext[i] = *(const u32x4*)(prow + (size_t)sx * INW + 3 * AW + 64 * n + 8 * lc); } }
#pragma unroll
        for (int t = 0; t < 32; ++t) {
            if ((t & 3) == 0) asm volatile("" ::: "memory");
            const float xc = xcv[t];
            const int te = (t & 3) + 4 * (t >> 3); const float prr = ((t >> 2) & 1) ? pr1[te] : pr0[te], pri = ((t >> 2) & 1) ? pi1[te] : pi0[te];
            const float r = __builtin_amdgcn_rcpf(1.0f + __builtin_amdgcn_exp2f(__builtin_fmaf(prr, -LOG2E, nbrg)));
            const float ig = __builtin_amdgcn_rcpf(1.0f + __builtin_amdgcn_exp2f(__builtin_fmaf(pri, -LOG2E, nbig)));
            const float a0 = __builtin_amdgcn_exp2f(cA * r); const float mult = __builtin_amdgcn_sqrtf(__builtin_fmaf(-a0, a0, 1.0f));
            const float bt = mult * (ig * xc); const float a = a0;
            if (!PASS_B) AB[(size_t)(st + t) * LW] = pk_bf16(cA * r, bt);
            h = __builtin_fmaf(a, h, bt);
            if (PASS_B) { const float gl = bf2f(glt[t * 64 + lane]);
                const float v = __builtin_fmaf(gl * gl, GELU_K * 0.044715f, GELU_K) * gl;
                const float ge = gl * __builtin_amdgcn_rcpf(1.0f + __builtin_amdgcn_exp2f(v));
                glt[t * 64 + lane] = (bf16)(pk_bf16(h * ge, 0.f) & 0xffffu); }
            else P *= a;
        }
        LDS_WAIT();
        if (PASS_B) {
#pragma unroll
            for (int i = 0; i < 4; ++i) { const u32x4 y = *(const LAS u32x4*)(glt + (8 * i + lr) * 64 + 8 * lc);
                *(u32x4*)(MIX + ((size_t)b * SEQ + st + 8 * i + lr) * DM + AW + 64 * n + 8 * lc) = y; }
            LDS_WAIT();
        }
    }
    if (!PASS_B) { f32x2 sv = {P, h}; SUMM[((size_t)b * NCH + j) * LW + c] = sv; }
}

__device__ __forceinline__ void lru_apply_unit(LAS unsigned char* wl, const bf16* PROJ, bf16* MIX, const f32x2* SUMM, const unsigned* ABbuf, int b, int j, int n, int lane) {
    LAS bf16* glt = (LAS bf16*)(wl + 8192);
    const int c = 64 * n + lane;
    constexpr float GELU_K = -2.0f * LOG2E * 0.7978845608028654f;
    const int s0 = j * LCH;
    const bf16* prow = PROJ + (size_t)b * SEQ * INW;
    const unsigned* AB = ABbuf + (size_t)b * SEQ * LW + c;
    const int lr = lane >> 3, lc = lane & 7;
    unsigned ab[2][32]; u32x4 gr[2][4];
#pragma unroll
    for (int tt = 0; tt < 2; ++tt) {
#pragma unroll
        for (int i = 0; i < 4; ++i) gr[tt][i] = *(const u32x4*)(prow + (size_t)(s0 + 32 * tt + 8 * i + lr) * INW + 3 * AW + LW + 64 * n + 8 * lc);
#pragma unroll
        for (int t = 0; t < 32; ++t) ab[tt][t] = AB[(size_t)(s0 + 32 * tt + t) * LW]; }
    float h = 0.f;
    { const f32x2* sp = SUMM + (size_t)b * NCH * LW + c; int jj = 0;
      for (; jj < j; jj += 16) { f32x2 sv[16];
#pragma unroll
          for (int q = 0; q < 16; ++q) { const int jq = jj + q < j ? jj + q : j - 1; sv[q] = sp[(size_t)jq * LW]; }
#pragma unroll
          for (int q = 0; q < 16; ++q) { const bool on = jj + q < j; h = (on ? sv[q][0] : 1.0f) * h + (on ? sv[q][1] : 0.f); } } }
#pragma unroll
    for (int tt = 0; tt < 2; ++tt)
#pragma unroll
        for (int i = 0; i < 4; ++i) *(LAS u32x4*)(glt + tt * 2048 + (8 * i + lr) * 64 + 8 * lc) = gr[tt][i];
    LDS_WAIT();
#pragma unroll
    for (int tt = 0; tt < 2; ++tt) {
#pragma unroll
        for (int t = 0; t < 32; ++t) {
            if ((t & 7) == 0) asm volatile("" ::: "memory");
            const float a = __builtin_amdgcn_exp2f(bf_lo(ab[tt][t]));
            h = __builtin_fmaf(a, h, bf_hi(ab[tt][t]));
            const float gl = bf2f(glt[tt * 2048 + t * 64 + lane]);
            const float v = __builtin_fmaf(gl * gl, GELU_K * 0.044715f, GELU_K) * gl;
            const float ge = gl * __builtin_amdgcn_rcpf(1.0f + __builtin_amdgcn_exp2f(v));
            glt[tt * 2048 + t * 64 + lane] = (bf16)(pk_bf16(h * ge, 0.f) & 0xffffu);
        }
    }
    LDS_WAIT();
#pragma unroll
    for (int tt = 0; tt < 2; ++tt)
#pragma unroll
        for (int i = 0; i < 4; ++i) { const u32x4 y = *(const LAS u32x4*)(glt + tt * 2048 + (8 * i + lr) * 64 + 8 * lc);
            *(u32x4*)(MIX + ((size_t)b * SEQ + s0 + 32 * tt + 8 * i + lr) * DM + AW + 64 * n + 8 * lc) = y; }
    LDS_WAIT();
}

constexpr float STICK_EXIT = 2.3283064365386963e-10f;
__device__ __forceinline__ void load_raw_frag(const bf16* p  , u32x4 (&raw)[4]) {
#pragma unroll
    for (int ks = 0; ks < 4; ++ks) raw[ks] = *(const u32x4*)(p + 16 * ks);
}
template <bool GAINS>
__device__ __forceinline__ void norm_frag(const u32x4 (&raw)[4], const float* g, const float* g2, int hi, float scale, bf16x8 (&f)[4]) {
    float ss = 0.f;
#pragma unroll
    for (int ks = 0; ks < 4; ++ks)
#pragma unroll
        for (int e = 0; e < 4; ++e) { const float a = bf_lo(raw[ks][e]), b2 = bf_hi(raw[ks][e]); ss += a * a + b2 * b2; }
    ss += xhalf(ss);
    const float rs = __builtin_amdgcn_rsqf(ss * (1.0f / 64.0f) + RMS_EPS) * scale;
#pragma unroll
    for (int ks = 0; ks < 4; ++ks) { u32x4 o;
        if (GAINS) { const f32x4 g0 = *(const f32x4*)(g + 16 * ks + 8 * hi) * *(const f32x4*)(g2 + 16 * ks + 8 * hi), g1 = *(const f32x4*)(g + 16 * ks + 8 * hi + 4) * *(const f32x4*)(g2 + 16 * ks + 8 * hi + 4);
            o[0] = pk_bf16(bf_lo(raw[ks][0]) * rs * g0[0], bf_hi(raw[ks][0]) * rs * g0[1]); o[1] = pk_bf16(bf_lo(raw[ks][1]) * rs * g0[2], bf_hi(raw[ks][1]) * rs * g0[3]);
            o[2] = pk_bf16(bf_lo(raw[ks][2]) * rs * g1[0], bf_hi(raw[ks][2]) * rs * g1[1]); o[3] = pk_bf16(bf_lo(raw[ks][3]) * rs * g1[2], bf_hi(raw[ks][3]) * rs * g1[3]); }
        else {
#pragma unroll
            for (int e = 0; e < 4; ++e) o[e] = pk_bf16(bf_lo(raw[ks][e]) * rs, bf_hi(raw[ks][e]) * rs); }
        f[ks] = __builtin_bit_cast(bf16x8, o); }
}
__device__ __forceinline__ void load_v_raw(const bf16* vtile  , int lane, u32x4 (&vr)[4]) {
#pragma unroll
    for (int i = 0; i < 4; ++i) vr[i] = *(const u32x4*)(vtile + (size_t)(8 * i + (lane >> 3)) * INW + 8 * (lane & 7));
}
__device__ __forceinline__ void store_v_lds(LAS bf16* vb, int lane, const u32x4 (&vr)[4]) {
#pragma unroll
    for (int i = 0; i < 4; ++i) *(LAS u32x4*)(vb + (8 * i + (lane >> 3)) * 64 + 8 * (lane & 7)) = vr[i];
}
__device__ __forceinline__ void read_v_frag(const LAS bf16* vb, int l32, int hi, bf16x8 (&vf)[2][2]) {
    const LAS bf16* vp = vb + 4 * hi * 64 + l32;
#pragma unroll
    for (int st = 0; st < 2; ++st)
#pragma unroll
        for (int i = 0; i < 8; ++i) { const int ko = 16 * st + 8 * (i >> 2) + (i & 3);
            vf[0][st][i] = (short)vp[ko * 64]; vf[1][st][i] = (short)vp[ko * 64 + 32]; }
}
__device__ __forceinline__ void attn_unit(LAS unsigned char* wl, const bf16* PROJ, bf16* MIX, const float* gq, const float* gk, int b, int h, int qt, int lane) {
    const int l32 = lane & 31, hi = lane >> 5;
    LAS bf16* vbuf = (LAS bf16*)wl;
    const bf16* prow = PROJ + (size_t)b * SEQ * INW;
    const int q0 = qt * 32;
    u32x4 qraw[4], kraw[4], vraw[4];
    load_raw_frag(prow + (size_t)(q0 + l32) * INW + h * HD + 8 * hi, qraw);
    load_raw_frag(prow + (size_t)(q0 + l32) * INW + AW + h * HD + 8 * hi, kraw);
    load_v_raw(prow + (size_t)q0 * INW + 2 * AW + h * HD, lane, vraw);
    bf16x8 qf[4];
    norm_frag<true>(qraw, gq, gk, hi, 0.125f * LOG2E, qf);
    store_v_lds(vbuf + (qt & 1) * 2048, lane, vraw);
    f32x16 O0, O1;
#pragma unroll
    for (int e = 0; e < 16; ++e) { O0[e] = 0.f; O1[e] = 0.f; }
    float R = 1.0f;
    for (int kt = qt; ; --kt) {
        const int kn = (kt > 0 ? kt - 1 : 0) * 32;
        u32x4 kraw_n[4];
        load_raw_frag(prow + (size_t)(kn + l32) * INW + AW + h * HD + 8 * hi, kraw_n);
        load_v_raw(prow + (size_t)kn * INW + 2 * AW + h * HD, lane, vraw);
        bf16x8 kf[4];
        norm_frag<false>(kraw, nullptr, nullptr, hi, 1.0f, kf);
        f32x16 S;
#pragma unroll
        for (int e = 0; e < 16; ++e) S[e] = 0.f;
#pragma unroll
        for (int ks = 0; ks < 4; ++ks) S = __builtin_amdgcn_mfma_f32_32x32x16_bf16(kf[ks], qf[ks], S, 0, 0, 0);
        LDS_WAIT();
        bf16x8 vf[2][2];
        read_v_frag(vbuf + (kt & 1) * 2048, l32, hi, vf);
        const bool diag = (kt == qt);
        float inv[16], bet[16], gp[4];
#pragma unroll
        for (int g = 0; g < 4; ++g) { float acc = 1.f;
#pragma unroll
            for (int e2 = 0; e2 < 4; ++e2) { const int e = 4 * g + e2;
                const float ez = __builtin_amdgcn_exp2f(fminf(S[e], 80.0f));
                const float iv = __builtin_amdgcn_rcpf(1.0f + ez);
                const bool masked = diag && ((e2 + 8 * g + 4 * hi) >= l32);
                inv[e] = masked ? 1.0f : iv; bet[e] = masked ? 0.f : ez * iv; acc *= inv[e]; }
            gp[g] = acc; }
        float ps[4];
#pragma unroll
        for (int g = 0; g < 4; ++g) ps[g] = xhalf(gp[g]);
        float right = R; float wv[16];
#pragma unroll
        for (int g = 3; g >= 0; --g) {
            float run = right * (hi == 0 ? ps[g] : 1.0f);
#pragma unroll
            for (int e2 = 3; e2 >= 0; --e2) { const int e = 4 * g + e2; wv[e] = bet[e] * run; run *= inv[e]; }
            right *= gp[g] * ps[g];
        }
        R = right;
        bf16x8 wf[2];
#pragma unroll
        for (int st = 0; st < 2; ++st) { u32x4 o;
#pragma unroll
            for (int e = 0; e < 4; ++e) o[e] = pk_bf16(wv[8 * st + 2 * e], wv[8 * st + 2 * e + 1]);
            wf[st] = __builtin_bit_cast(bf16x8, o); }
#pragma unroll
        for (int st = 0; st < 2; ++st) { O0 = __builtin_amdgcn_mfma_f32_32x32x16_bf16(vf[0][st], wf[st], O0, 0, 0, 0); O1 = __builtin_amdgcn_mfma_f32_32x32x16_bf16(vf[1][st], wf[st], O1, 0, 0, 0); }
        if (kt == 0 || (!diag && __all(R < STICK_EXIT))) break;
#pragma unroll
        for (int ks = 0; ks < 4; ++ks) kraw[ks] = kraw_n[ks];
        store_v_lds(vbuf + ((kt - 1) & 1) * 2048, lane, vraw);
    }
    bf16* orow = MIX + ((size_t)b * SEQ + q0 + l32) * DM + h * HD;
#pragma unroll
    for (int g = 0; g < 4; ++g) { u32x2 a, c2; a[0] = pk_bf16(O0[4 * g], O0[4 * g + 1]); a[1] = pk_bf16(O0[4 * g + 2], O0[4 * g + 3]); c2[0] = pk_bf16(O1[4 * g], O1[4 * g + 1]); c2[1] = pk_bf16(O1[4 * g + 2], O1[4 * g + 3]);
        *(u32x2*)(orow + 8 * g + 4 * hi) = a; *(u32x2*)(orow + 32 + 8 * g + 4 * hi) = c2; }
    LDS_WAIT();
}

#define XB_TMO      128
#define XB_XCNT(j)  (256  + 64 * (j))
#define XB_XSUB(j)  (1280 + 64 * (j))
#define XB_XGEN(j)  (2304 + 64 * (j))
#define XB_TOP      3328
#define XB_TOPGEN   3392
#define XCD_BAR_WORDS 3456
#define XB_SPIN_CAP (1u << 18)

__device__ __forceinline__ unsigned xb_ld(unsigned* p)              { return __hip_atomic_load(p, __ATOMIC_RELAXED, __HIP_MEMORY_SCOPE_AGENT); }
__device__ __forceinline__ unsigned xb_add(unsigned* p, unsigned v) { return __hip_atomic_fetch_add(p, v, __ATOMIC_RELAXED, __HIP_MEMORY_SCOPE_AGENT); }
__device__ __forceinline__ unsigned xb_xcc_id() { return (unsigned)__builtin_amdgcn_s_getreg((3 << 11) | 20) & 0xFu; }
#define XB_SPIN(cond, bar) do { unsigned _sp = 0; while (cond) { __builtin_amdgcn_s_sleep(1); \
    if ((++_sp & 255u) == 0u) { if (xb_ld(&(bar)[XB_TMO])) break; if (_sp > XB_SPIN_CAP) { atomicAdd(&(bar)[XB_TMO], 1u); break; } } } } while (0)

struct XcdBarrier {
    unsigned* bar; unsigned x;
    volatile LAS unsigned* st;
};

__device__ __forceinline__ XcdBarrier xcd_barrier_post(unsigned* bar, volatile LAS unsigned* st) {
    XcdBarrier b; b.bar = bar; b.x = xb_xcc_id(); b.st = st;
    if (threadIdx.x == 0) (void)xb_add(&bar[XB_XCNT(b.x)], 1u);
    return b;
}
__device__ __forceinline__ void xcd_barrier_complete(unsigned* bar, unsigned x, unsigned& nloc, unsigned& nx) {
    const unsigned G = gridDim.x * gridDim.y * gridDim.z;
    unsigned sum, cnt, mine, sp = 0u;
    for (;;) {
        sum = 0u; cnt = 0u; mine = 0u;
#pragma unroll
        for (unsigned j = 0; j < 16; ++j) { const unsigned c = xb_ld(&bar[XB_XCNT(j)]); sum += c; cnt += (c > 0u) ? 1u : 0u; mine = (j == x) ? c : mine; }
        if (sum == G) break;
        __builtin_amdgcn_s_sleep(1);
        if ((++sp & 255u) == 0u) { if (xb_ld(&bar[XB_TMO])) break; if (sp > XB_SPIN_CAP) { atomicAdd(&bar[XB_TMO], 1u); break; } }
    }
    nloc = mine > 0u ? mine : 1u; nx = cnt > 0u ? cnt : 1u;
}

__device__ __forceinline__ void xcd_barrier(const XcdBarrier& b) {
    asm volatile("s_waitcnt vmcnt(0)" ::: "memory");
    __syncthreads();
    if (threadIdx.x == 0) {
        unsigned* bar = b.bar;
        __builtin_amdgcn_s_waitcnt(0);
        unsigned nloc = b.st[0], nx = b.st[1];
        if (nloc == 0u) { xcd_barrier_complete(bar, b.x, nloc, nx); b.st[0] = nloc; b.st[1] = nx; }
        const unsigned old = xb_add(&bar[XB_XSUB(b.x)], 1u);
        const unsigned gen = old / nloc;
        if (old + 1u == (gen + 1u) * nloc) {
            __builtin_amdgcn_fence(__ATOMIC_RELEASE, "agent");
            asm volatile("s_waitcnt vmcnt(0)" ::: "memory");
            const unsigned og = xb_add(&bar[XB_TOP], 1u);
            const unsigned tg = og / nx;
            if (og + 1u == (tg + 1u) * nx) xb_add(&bar[XB_TOPGEN], 1u);
            else XB_SPIN(xb_ld(&bar[XB_TOPGEN]) == tg, bar);
            __builtin_amdgcn_fence(__ATOMIC_ACQUIRE, "agent");
            xb_add(&bar[XB_XGEN(b.x)], 1u);
            asm volatile("s_waitcnt vmcnt(0)" ::: "memory");
        } else {
            XB_SPIN(xb_ld(&bar[XB_XGEN(b.x)]) == gen, bar);
            __builtin_amdgcn_fence(__ATOMIC_ACQUIRE, "agent");
            asm volatile("s_waitcnt vmcnt(0)" ::: "memory");
        }
    }
    __syncthreads();
}

__device__ __forceinline__ void xcd_split_arrive(unsigned* bar2, const XcdBarrier& b) {
    asm volatile("s_waitcnt vmcnt(0)" ::: "memory");
    __syncthreads();
    if (threadIdx.x == 0) {
        unsigned nloc = b.st[0];
        if (nloc == 0u) { unsigned nx; xcd_barrier_complete(b.bar, b.x, nloc, nx); b.st[0] = nloc; b.st[1] = nx; }
        const unsigned old = xb_add(&bar2[XB_XSUB(b.x)], 1u);
        if ((old + 1u) % nloc == 0u) {
            __builtin_amdgcn_fence(__ATOMIC_RELEASE, "agent");
            asm volatile("s_waitcnt vmcnt(0)" ::: "memory");
            (void)xb_add(&bar2[XB_TOP], 1u);
        }
    }
}
__device__ __forceinline__ void xcd_split_wait(unsigned* bar2, const XcdBarrier& b, unsigned round) {
    if (threadIdx.x == 0) {
        const unsigned want = b.st[1] * round;
        XB_SPIN(xb_ld(&bar2[XB_TOP]) < want, b.bar);
        __builtin_amdgcn_fence(__ATOMIC_ACQUIRE, "agent");
        asm volatile("s_waitcnt vmcnt(0)" ::: "memory");
    }
    __syncthreads();
}

constexpr int CONV_CHUNK = 1536, CONV_TOTAL = DEPTH * I_LAYERW;
__device__ __forceinline__ void convert_chunk(const In& I, unsigned char* ws, LAS float* scr, int k, int w, int NW, int lane) {
    const int glo = I_IN + CONV_CHUNK * k; int ghi = glo + CONV_CHUNK; if (ghi > CONV_TOTAL) ghi = CONV_TOTAL;
    int it = glo + w; if (k < 0 || it >= ghi) return;
    TItem cur = resolve_w(I, ws, it / I_LAYERW, it % I_LAYERW); float va[32]; titem_load(cur, lane, va);
    for (;;) {
        const int nx = it + NW; const bool more = nx < ghi;
        TItem nxt = cur; float vb[32];
        if (more) { nxt = resolve_w(I, ws, nx / I_LAYERW, nx % I_LAYERW); titem_load(nxt, lane, vb); }
        titem_finish(cur, scr, lane, va);
        if (!more) break;
        cur = nxt; it = nx;
#pragma unroll
        for (int i = 0; i < 32; ++i) va[i] = vb[i];
    }
}

#ifndef RESID_LO
#define RESID_LO false
#endif
#ifndef REP_P0
#define REP_P0 1
#endif
#ifndef REP_M1
#define REP_M1 1
#endif
#ifndef REP_M2
#define REP_M2 1
#endif
#ifndef REP_G1
#define REP_G1 1
#endif
#ifndef REP_G3
#define REP_G3 1
#endif
#ifndef REP_G2
#define REP_G2 1
#endif
#ifndef REP_G4
#define REP_G4 1
#endif
struct Params { const float* in[16]; float* out; unsigned char* ws; int ph_lo, ph_hi; };
constexpr int N_PHASES = 1 + 6 * DEPTH;
__global__ void __launch_bounds__(NWAVES * 64, 2) fwd_megakernel(Params p) {
    extern __shared__ __attribute__((aligned(16))) unsigned char lds_raw[];
    LAS unsigned char* lds = (LAS unsigned char*)lds_raw;
    cg::grid_group grid = cg::this_grid();
    const int tid = threadIdx.x, lane0 = tid & 63, wave = __builtin_amdgcn_readfirstlane(tid >> 6);
    const int G = gridDim.x, gw = blockIdx.x * NWAVES + wave, NGW = G * NWAVES;
    In I; I.x = p.in[0]; I.norm1_g = p.in[1]; I.w_in = p.in[2]; I.conv_w = p.in[3]; I.conv_b = p.in[4]; I.w_rg = p.in[5]; I.b_rg = p.in[6]; I.w_ig = p.in[7]; I.b_ig = p.in[8];
    I.lam = p.in[9]; I.qg = p.in[10]; I.kg = p.in[11]; I.w_out = p.in[12]; I.norm2_g = p.in[13]; I.w_up = p.in[14]; I.w_down = p.in[15];
    const int lo = p.ph_lo, hi = p.ph_hi;
#define IN(k) (lo <= (k) && (k) < hi)
#define SEAM(k) do { if (IN(k) && IN((k) + 1)) xcd_barrier(bar); } while (0)
#define LAUNDER(x) asm volatile("" : "+s"(x))
    volatile LAS unsigned* MISC = (volatile LAS unsigned*)(lds + LDS_MISC);
    if (tid < 64) MISC[tid] = 0u;
    __syncthreads();
    XcdBarrier bar; bar.bar = (unsigned*)(p.ws + WS_BAR); bar.x = 0; bar.st = MISC + 8;
    if (hi - lo > 1) bar = xcd_barrier_post((unsigned*)(p.ws + WS_BAR), MISC + 8);
#define SPLIT_SEAM(k, round, chunk) do { if (IN(k)) { unsigned char* ws_ = p.ws; LAUNDER(ws_); int lane_ = lane0; asm volatile("" : "+v"(lane_)); const bool in_ = IN((k) + 1); \
        if (in_) xcd_split_arrive((unsigned*)(ws_ + WS_BAR) + XCD_BAR_WORDS, bar); \
        convert_chunk(I, ws_, (LAS float*)(lds + wave * LRU_WAVE_LDS), (chunk), gw, NGW, lane_); \
        if (in_) xcd_split_wait((unsigned*)(ws_ + WS_BAR) + XCD_BAR_WORDS, bar, (unsigned)(round)); } } while (0)
    if (IN(0)) { for (int rep = 0; rep < REP_P0; ++rep) p0_prologue(I, p.ws, lds, gw, NGW, wave, lane0); }
    SPLIT_SEAM(0, 1, 0);
    for (int l = 0; l < DEPTH; ++l) {
        const int pb = 1 + 6 * l;
        if (IN(pb + 0)) {
            unsigned char* ws = p.ws; LAUNDER(ws);
            pg8::Gemm g{(const bf16*)(ws + WS_XB), (const bf16*)(ws + WS_W + (size_t)l * W_LAYER + W_IN_OFF), M, 4 * AW, DM}; pg8::StaticOrder S; S.init(M, 4 * AW, G, (int)blockIdx.x);
            pg8::EpiScaleBf16<0> E{(bf16*)(ws + WS_PROJ), INW, (const float*)(ws + WS_SSQA)};
            for (int rep = 0; rep < REP_G1; ++rep) pg8::gemm_phase<pg8::EpiScaleBf16<0>, pg8::StaticOrder, true, true>(lds, g, S, E);
            if (IN(pb + 1)) xcd_split_arrive((unsigned*)(ws + WS_BAR) + XCD_BAR_WORDS, bar);
        }
        if (IN(pb + 1)) {
            unsigned char* ws = p.ws; LAUNDER(ws); int lane = lane0; asm volatile("" : "+v"(lane));
            unsigned* bar2 = (unsigned*)(ws + WS_BAR) + XCD_BAR_WORDS;
            const int half = G >> 1; const bool gemm_wg = (int)blockIdx.x < half;
            const bool xmap = (G == 256); const int xb = ((int)blockIdx.x & 7) >> 1, xh = (int)blockIdx.x & 1, lwx = (((int)blockIdx.x >> 3) & 15) * NWAVES + wave;
            if (gemm_wg) {
                pg8::Gemm g{(const bf16*)(ws + WS_XB), (const bf16*)(ws + WS_W + (size_t)l * W_LAYER + W_IN_OFF) + (size_t)4 * AW * DM, M, LW, DM}; pg8::StaticOrder S; S.init(M, LW, half, (int)blockIdx.x);
                pg8::EpiScaleBf16<0> E{(bf16*)(ws + WS_PROJ) + 4 * AW, INW, (const float*)(ws + WS_SSQA)};
                pg8::gemm_phase<pg8::EpiScaleBf16<0>, pg8::StaticOrder, false, true>(lds, g, S, E);
            }
            const bool seam0_inside = IN(pb + 0);
            if (gemm_wg && seam0_inside) xcd_split_wait(bar2, bar, (unsigned)(2 + 6 * l));
            LAUNDER(ws); asm volatile("" : "+v"(lane));
            constexpr int NATT = BATCH * NH * (SEQ / 32), NATT_B = NATT / 2;
            const int nw1 = half * NWAVES, nw2 = (G - half) * NWAVES;
            const int wi = gemm_wg ? gw : gw - nw1;
            if (!gemm_wg) {
                if (seam0_inside) xcd_split_wait(bar2, bar, (unsigned)(2 + 6 * l));
                LruW lw; lw.conv_w = I.conv_w + l * 4 * LW; lw.conv_b = I.conv_b + l * LW; lw.b_rg = I.b_rg + l * LW; lw.b_ig = I.b_ig + l * LW; lw.lam = I.lam + l * LW;
                lw.wrgT = (const bf16*)(ws + WS_GATE) + (size_t)(l * 2 + 0) * NLB * 4096; lw.wigT = (const bf16*)(ws + WS_GATE) + (size_t)(l * 2 + 1) * NLB * 4096;
                for (int u = wi; u < BATCH * NCH * NLB; u += nw2) { int n = u % NLB, j = (u / NLB) % NCH, b = u / (NLB * NCH);
                    if (xmap) { const int lu = lwx + 128 * ((u - wi) / nw2); n = lu % NLB; j = 32 * xh + lu / NLB; b = xb; }
#ifndef NO_LRU
                    lru_unit<false>(lds + wave * LRU_WAVE_LDS, (const bf16*)(ws + WS_PROJ), (bf16*)(ws + WS_MIX), (f32x2*)(ws + WS_SUMM), (unsigned*)(ws + WS_AB), lw, b, j, n, lane);
#endif
                }
                LAUNDER(ws); asm volatile("" : "+v"(lane));
            }
            const bool seam_inside = IN(pb + 2);
            if (seam_inside) xcd_split_arrive(bar2, bar);
            const int ubeg = gemm_wg ? NATT_B + wi : wi, uend = gemm_wg ? NATT : NATT_B, ustep = gemm_wg ? nw1 : nw2;
            for (int u = ubeg; u < uend; u += ustep) { int qt = u % (SEQ / 32), hh = (u / (SEQ / 32)) % NH, b = u / ((SEQ / 32) * NH);
                if (xmap) { const int au = (gemm_wg ? 256 : 0) + lwx + 128 * ((u - ubeg) / ustep); hh = au % NH; qt = 64 * xh + au / NH; b = xb; }
#ifndef NO_ATT
                attn_unit(lds + wave * LRU_WAVE_LDS, (const bf16*)(ws + WS_PROJ), (bf16*)(ws + WS_MIX), I.qg + l * HD, I.kg + l * HD, b, hh, qt, lane);
#endif
            }
            if (seam_inside) xcd_split_wait(bar2, bar, (unsigned)(3 + 6 * l));
        }
        if (IN(pb + 2)) {
            unsigned char* ws = p.ws; LAUNDER(ws); int lane = lane0; asm volatile("" : "+v"(lane));
            const bool xmap = (G == 256); const int xb = ((int)blockIdx.x & 7) >> 1, xh = (int)blockIdx.x & 1, lw2 = ((int)blockIdx.x >> 3) * NWAVES + wave;
            for (int u = gw; u < BATCH * NCH * NLB; u += NGW) { int n = u % NLB, j = (u / NLB) % NCH, b = u / (NLB * NCH);
                if (xmap) { n = lw2 % NLB; j = 32 * xh + lw2 / NLB; b = xb; }
#ifndef NO_LRU
                lru_apply_unit(lds + wave * LRU_WAVE_LDS, (const bf16*)(ws + WS_PROJ), (bf16*)(ws + WS_MIX), (const f32x2*)(ws + WS_SUMM), (const unsigned*)(ws + WS_AB), b, j, n, lane);
#endif
            }
        }
        SPLIT_SEAM(pb + 2, 4 + 6 * l, 1 + 4 * l);
        if (IN(pb + 3)) {
            unsigned char* ws = p.ws; LAUNDER(ws);
            pg8::Gemm g{(const bf16*)(ws + WS_MIX), (const bf16*)(ws + WS_W + (size_t)l * W_LAYER + W_OUT_OFF), M, DM, DM}; pg8::StaticOrder S; S.init(M, DM, G, (int)blockIdx.x);
            if (RESID_LO && l == 0) { pg8::EpiResid<true, false, RESID_LO> E{I.x, nullptr, nullptr, nullptr, (bf16*)(ws + WS_XB), (bf16*)(ws + WS_LO1), (float*)(ws + WS_SSQB), 1.0f};
                pg8::gemm_phase<pg8::EpiResid<true, false, RESID_LO>, pg8::StaticOrder, false, true>(lds, g, S, E); }
            else { pg8::EpiResid<false, false, RESID_LO> E{nullptr, (const bf16*)(ws + WS_XB), (const bf16*)p.out  , nullptr, (bf16*)(ws + WS_XB), (bf16*)(ws + WS_LO1), (float*)(ws + WS_SSQB), 1.0f};
                pg8::gemm_phase<pg8::EpiResid<false, false, RESID_LO>, pg8::StaticOrder, false, true>(lds, g, S, E); }
        }
        SPLIT_SEAM(pb + 3, 5 + 6 * l, 2 + 4 * l);
        if (IN(pb + 4)) {
            unsigned char* ws = p.ws; LAUNDER(ws);
            pg8::Gemm g{(const bf16*)(ws + WS_XB), (const bf16*)(ws + WS_W + (size_t)l * W_LAYER + W_UP_OFF), M, FF, DM}; pg8::StaticOrder S; S.init(M, FF, G, (int)blockIdx.x);
            pg8::EpiScaleBf16<1> E{(bf16*)(ws + WS_H), FF, (const float*)(ws + WS_SSQB)};
            for (int rep = 0; rep < REP_G3; ++rep) pg8::gemm_phase<pg8::EpiScaleBf16<1>, pg8::StaticOrder, true, true>(lds, g, S, E);
        }
        SPLIT_SEAM(pb + 4, 6 + 6 * l, 3 + 4 * l);
        if (IN(pb + 5)) {
            unsigned char* ws = p.ws; LAUNDER(ws);
            pg8::Gemm g{(const bf16*)(ws + WS_H), (const bf16*)(ws + WS_W + (size_t)l * W_LAYER + W_DOWN_OFF), M, DM, FF}; pg8::StaticOrder S; S.init(M, DM, G, (int)blockIdx.x);
            if (l + 1 < DEPTH) { pg8::EpiResid<false, false, RESID_LO> E{nullptr, (const bf16*)(ws + WS_XB), (const bf16*)(ws + WS_LO1), nullptr, (bf16*)(ws + WS_XB), (bf16*)p.out  , (float*)(ws + WS_SSQA), 1.0f};
                pg8::gemm_phase<pg8::EpiResid<false, false, RESID_LO>, pg8::StaticOrder, false, true>(lds, g, S, E); }
            else { pg8::EpiResid<false, true, RESID_LO> E{nullptr, (const bf16*)(ws + WS_XB), (const bf16*)(ws + WS_LO1), p.out, nullptr, nullptr, nullptr, 1.0f};
                pg8::gemm_phase<pg8::EpiResid<false, true, RESID_LO>, pg8::StaticOrder, false, true>(lds, g, S, E); }
        }
        if (l + 1 < DEPTH) SPLIT_SEAM(pb + 5, 7 + 6 * l, 4 + 4 * l);
    }
#undef SPLIT_SEAM
#undef IN
#undef SEAM
}

#ifndef MK_N_LAUNCHES
#define MK_N_LAUNCHES 1
#endif
extern "C" void kernel_launch(void* const* d_in, const int* in_sizes, int n_in, void* d_out, int out_size, void* d_ws, size_t ws_size, hipStream_t stream) {
    static int grid = 0;
    if (grid == 0) {
        if (n_in != 16 || out_size != M * DM || ws_size < WS_END) { fprintf(stderr, "kernel_launch: unexpected shapes (n_in %d out %d ws %zu)\n", n_in, out_size, ws_size); grid = -1; return; }
        int dev = 0, cus = 0, per_cu = 0;
        (void)hipGetDevice(&dev); (void)hipDeviceGetAttribute(&cus, hipDeviceAttributeMultiprocessorCount, dev);
        if (hipFuncSetAttribute((const void*)fwd_megakernel, hipFuncAttributeMaxDynamicSharedMemorySize, LDS_BYTES) != hipSuccess) { fprintf(stderr, "kernel_launch: hipFuncSetAttribute failed\n"); grid = -1; return; }
        if (hipOccupancyMaxActiveBlocksPerMultiprocessor(&per_cu, (const void*)fwd_megakernel, NWAVES * 64, LDS_BYTES) != hipSuccess || per_cu < 1) { fprintf(stderr, "kernel_launch: occupancy query gave %d\n", per_cu); per_cu = 1; }
        (void)hipGetLastError();
        grid = cus * per_cu;
        fprintf(stderr, "kernel_launch: grid %d (cus %d x %d)\n", grid, cus, per_cu);
    }
    if (grid < 0) return;
    Params a{};
    for (int i = 0; i < 16; ++i) a.in[i] = (const float*)d_in[i];
    a.out = (float*)d_out; a.ws = (unsigned char*)d_ws;
    if (MK_N_LAUNCHES == 1) {
        a.ph_lo = 0; a.ph_hi = N_PHASES;
        if (hipMemsetAsync((unsigned char*)d_ws + WS_BAR, 0, 2 * XCD_BAR_WORDS * sizeof(unsigned), stream) != hipSuccess) { fprintf(stderr, "kernel_launch: hipMemsetAsync of the barrier words failed\n"); return; }
        void* args[] = {&a};
        hipError_t e = hipLaunchCooperativeKernel((const void*)fwd_megakernel, dim3(grid), dim3(NWAVES * 64), args, LDS_BYTES, stream);
        if (e != hipSuccess) fprintf(stderr, "cooperative launch failed: %s (grid %d)\n", hipGetErrorString(e), grid);
    } else {
        for (int ph = 0; ph < N_PHASES; ++ph) { a.ph_lo = ph; a.ph_hi = ph + 1; hipLaunchKernelGGL(fwd_megakernel, dim3(grid), dim3(NWAVES * 64), LDS_BYTES, stream, a); }
    }
}
```

```cpp
#include <hip/hip_runtime.h>
#include <hip/hip_cooperative_groups.h>
#include <cstdio>
#include <cstdint>
namespace cg = cooperative_groups;
namespace pg8 {
#define PG8_LAS __attribute__((address_space(3)))
typedef unsigned short bf16_t;
typedef short bf16x8 __attribute__((ext_vector_type(8)));
typedef float f32x4 __attribute__((ext_vector_type(4)));
typedef unsigned u32x4 __attribute__((ext_vector_type(4)));
constexpr int BM = 256, BK = 64, HALF = 128, HTB = HALF * BK * 2  , STAGE_BYTES = 8 * HTB, NXCD = 8, WGM = 8;

__host__ __device__ __forceinline__ int lds_byte(int r, int c) { const int st = (r >> 4) * 2 + (c >> 5), rr = r & 15, cc = c & 31, ob = rr * 64 + cc * 2; return st * 1024 + (ob ^ (((ob >> 9) & 1) << 5)); }
__host__ __device__ __forceinline__ void stage_rc(int b, int& R, int& C) { const int st = b / 1024, sb = b % 1024, swz = sb ^ (((sb >> 9) & 1) << 5); R = (st >> 1) * 16 + swz / 64; C = (st & 1) * 32 + (swz % 64) / 2; }
__host__ __device__ __forceinline__ int perm32(int rho) { const int n = rho >> 4, i = rho & 15; return 8 * (i >> 2) + 4 * n + (i & 3); }

struct Unit { int pm, pn; };
struct Gemm { const bf16_t* A; const bf16_t* Bt; int M, N, K; };

struct StaticOrder {
    int nM, nN, nwg, G, c;
    __host__ __device__ void init(int M, int N, int G_, int c_) { nM = M / BM; nN = N / BM; nwg = nM * nN; G = G_; c = c_; }
    __host__ __device__ bool next(int i, Unit& u) const {
        const long L = (long)i * G + c; if (L >= nwg) return false;
        int wgid = (int)L; { const int q = nwg / NXCD, r = nwg % NXCD, xcd = wgid % NXCD, off = wgid / NXCD; wgid = (xcd < r ? xcd * (q + 1) : r * (q + 1) + (xcd - r) * q) + off; }
        const int nig = WGM * nN, gid = wgid / nig, fm = gid * WGM, gsz = (nM - fm) < WGM ? (nM - fm) : WGM;
        u.pm = fm + ((wgid % nig) % gsz); u.pn = (wgid % nig) / gsz; return true;
    }
    __device__ __forceinline__ void a_ready(const Unit&) const {}
    __device__ __forceinline__ void done(const Unit&) const {}
};

__device__ __forceinline__ unsigned cvt_pk_bf16(float lo, float hi) { unsigned r; asm volatile("v_cvt_pk_bf16_f32 %0, %1, %2" : "=v"(r) : "v"(lo), "v"(hi)); return r; }
__device__ __forceinline__ float lane_xor32(float v) { const auto r = __builtin_amdgcn_permlane32_swap(__float_as_uint(v), __float_as_uint(v), false, false); return __uint_as_float((threadIdx.x & 32) ? r[0] : r[1]); }
__device__ __forceinline__ float lane_xor16(float v) { const auto r = __builtin_amdgcn_permlane16_swap(__float_as_uint(v), __float_as_uint(v), false, false); return __uint_as_float((threadIdx.x & 16) ? r[0] : r[1]); }
constexpr float RMS_EPS = 1e-6f;
template <int ACT> struct EpiScaleBf16 {
    static constexpr bool PERM = true, AFTER_DRAIN = false;
    bf16_t* O; int ldc; const float* ssq;
    __device__ __forceinline__ void operator()(const f32x4 (&acc)[2][2][4][2], const Unit& u, int wr, int wc, int fr, int fq) const {
        const int row0 = u.pm * BM + wr * 64 + fr; const int col0 = u.pn * BM + wc * 32 + 8 * fq;
#pragma unroll
        for (int ai = 0; ai < 2; ++ai)
#pragma unroll
            for (int m = 0; m < 4; ++m) { const int row = row0 + ai * HALF + m * 16;
                const f32x4 sv = *(const f32x4*)(ssq + (size_t)row * 16 + 4 * fq); float s = (sv[0] + sv[1]) + (sv[2] + sv[3]);
                s += lane_xor16(s); s += lane_xor32(s);
                const float rs = __builtin_amdgcn_rsqf(s * (1.0f / 1024.0f) + RMS_EPS);
                bf16_t* rowp = O + (size_t)row * ldc + col0;
#pragma unroll
                for (int bj = 0; bj < 2; ++bj) { f32x4 v0 = acc[ai][bj][m][0] * rs, v1 = acc[ai][bj][m][1] * rs;
                    if (ACT == 1) {
#pragma unroll
                        for (int e = 0; e < 4; ++e) { const float a = fmaxf(v0[e], 0.f), b = fmaxf(v1[e], 0.f); v0[e] = a * a; v1[e] = b * b; } }
                    u32x4 w; w.x = cvt_pk_bf16(v0[0], v0[1]); w.y = cvt_pk_bf16(v0[2], v0[3]); w.z = cvt_pk_bf16(v1[0], v1[1]); w.w = cvt_pk_bf16(v1[2], v1[3]);
                    *(u32x4*)(rowp + bj * HALF) = w; } }
    }
};
template <bool BASE_F32, bool OUT_F32, bool USE_LO> struct EpiResid {
    static constexpr bool PERM = false, AFTER_DRAIN = false;
    const float* base_f; const bf16_t* base_hi; const bf16_t* base_lo; float* out_f; bf16_t* out_hi; bf16_t* out_lo; float* ssq_out; float accs;
    __device__ __forceinline__ void operator()(const f32x4 (&acc)[2][2][4][2], const Unit& u, int wr, int wc, int fr, int fq) const {
        typedef unsigned u32x2v __attribute__((ext_vector_type(2)));
        const int col0 = u.pn * BM + wc * 32 + 4 * fq;
#pragma unroll
        for (int ai = 0; ai < 2; ++ai) {
            f32x4 pre[4][2][2]; u32x2v ph[4][2][2], pl[4][2][2];
#pragma unroll
            for (int m = 0; m < 4; ++m) { const size_t off = (size_t)(u.pm * BM + ai * HALF + wr * 64 + m * 16 + fr) * 1024 + col0;
#pragma unroll
                for (int bj = 0; bj < 2; ++bj)
#pragma unroll
                    for (int n = 0; n < 2; ++n) {
                        if (BASE_F32) pre[m][bj][n] = *(const f32x4*)(base_f + off + bj * HALF + n * 16);
                        else { ph[m][bj][n] = *(const u32x2v*)(base_hi + off + bj * HALF + n * 16); if (USE_LO) pl[m][bj][n] = *(const u32x2v*)(base_lo + off + bj * HALF + n * 16); } } }
#pragma unroll
            for (int m = 0; m < 4; ++m) { const int r = u.pm * BM + ai * HALF + wr * 64 + m * 16 + fr; const size_t off = (size_t)r * 1024 + col0; float s = 0.f;
#pragma unroll
                for (int bj = 0; bj < 2; ++bj)
#pragma unroll
                    for (int n = 0; n < 2; ++n) { f32x4 bs;
                        if (BASE_F32) bs = pre[m][bj][n];
                        else { const u32x2v h = ph[m][bj][n]; u32x2v l = {0u, 0u}; if (USE_LO) l = pl[m][bj][n];
                            bs[0] = __uint_as_float(h.x << 16) + __uint_as_float(l.x << 16); bs[1] = __uint_as_float(h.x & 0xffff0000u) + __uint_as_float(l.x & 0xffff0000u);
                            bs[2] = __uint_as_float(h.y << 16) + __uint_as_float(l.y << 16); bs[3] = __uint_as_float(h.y & 0xffff0000u) + __uint_as_float(l.y & 0xffff0000u); }
                        const f32x4 o = bs + acc[ai][bj][m][n] * accs;
                        if (OUT_F32) *(f32x4*)(out_f + off + bj * HALF + n * 16) = o;
                        else { s += (o[0] * o[0] + o[1] * o[1]) + (o[2] * o[2] + o[3] * o[3]);
                            u32x2v w; w.x = cvt_pk_bf16(o[0], o[1]); w.y = cvt_pk_bf16(o[2], o[3]); *(u32x2v*)(out_hi + off + bj * HALF + n * 16) = w;
                            if (USE_LO) { u32x2v e; e.x = cvt_pk_bf16(o[0] - __uint_as_float(w.x << 16), o[1] - __uint_as_float(w.x & 0xffff0000u));
                            e.y = cvt_pk_bf16(o[2] - __uint_as_float(w.y << 16), o[3] - __uint_as_float(w.y & 0xffff0000u)); *(u32x2v*)(out_lo + off + bj * HALF + n * 16) = e; } } }
                if (!OUT_F32) { s += lane_xor16(s); s += lane_xor32(s);
                    if (fq == 0) ssq_out[(size_t)r * 16 + u.pn * 4 + wc] = s; } }
            asm volatile("" ::: "memory");
        }
    }
};
template <class Epi, class Sched, bool ALIGN_EPI = false, bool SP2 = false>
__device__ __forceinline__ void gemm_phase(PG8_LAS unsigned char* lds, const Gemm g, const Sched& S, const Epi& E) {
    int tid_ = threadIdx.x; asm volatile("" : "+v"(tid_));
    const int tid = tid_, wid = __builtin_amdgcn_readfirstlane(tid >> 6), lane = tid & 63, wr = wid >> 2, wc = wid & 3, fr = lane & 15, fq = lane >> 4;
    const int K = g.K, nt = K / BK;
    unsigned voffA[2], voffB[2];
#pragma unroll
    for (int i = 0; i < 2; ++i) { int R, C; stage_rc(tid * 16 + i * 8192, R, C); const int Rb = Epi::PERM ? ((R & ~31) + perm32(R & 31)) : R;
        voffA[i] = (unsigned)(R * K + C) * 2u; voffB[i] = (unsigned)(Rb * K + C) * 2u; }
    const size_t kstep = (size_t)(BK * 2);
    const size_t hstep = (size_t)HALF * K * 2;
    const size_t tstep = 2 * hstep;
    const unsigned ldsw = (unsigned)wid * 1024u;
    const int aoff = lds_byte(wr * 64 + fr, fq * 8), boff = lds_byte(wc * 32 + fr, fq * 8);
#define PG8_SA(b, h) (((b) * 2 + (h)) * HTB)
#define PG8_SB(b, h) ((4 + (b) * 2 + (h)) * HTB)
#define PG8_STAGE(bufoff, gbase, voff) do { _Pragma("unroll") for (int _i = 0; _i < 2; ++_i) \
        __builtin_amdgcn_global_load_lds((const unsigned*)((const char*)(gbase) + (voff)[_i]), (PG8_LAS unsigned*)(lds + (bufoff) + ldsw + _i * 8192), 16, 0, 0); } while (0)
#define PG8_LDA(dst, b, h) do { _Pragma("unroll") for (int m = 0; m < 4; ++m) _Pragma("unroll") for (int k = 0; k < 2; ++k) dst[m][k] = *(const PG8_LAS bf16x8*)(lds + PG8_SA(b, h) + aoff + m * 2048 + k * 1024); } while (0)
#define PG8_LDB(dst, b, h) do { _Pragma("unroll") for (int n = 0; n < 2; ++n) _Pragma("unroll") for (int k = 0; k < 2; ++k) dst[n][k] = *(const PG8_LAS bf16x8*)(lds + PG8_SB(b, h) + boff + n * 2048 + k * 1024); } while (0)
#define PG8_MMA(ai, bj, At, Bt) do { __builtin_amdgcn_s_setprio(1); _Pragma("unroll") for (int m = 0; m < 4; ++m) _Pragma("unroll") for (int n = 0; n < 2; ++n) _Pragma("unroll") for (int k = 0; k < 2; ++k) \
        acc[ai][bj][m][n] = __builtin_amdgcn_mfma_f32_16x16x32_bf16(Bt[n][k], At[m][k], acc[ai][bj][m][n], 0, 0, 0); __builtin_amdgcn_s_setprio(0); } while (0)
#define PG8_WAIT_V(n) asm volatile("s_waitcnt vmcnt(" #n ")" ::: "memory")
#define PG8_WAIT_L(n) asm volatile("s_waitcnt lgkmcnt(" #n ")" ::: "memory")
#define PG8_BAR __builtin_amdgcn_s_barrier()
#define PG8_SCHED __builtin_amdgcn_sched_barrier(0)
    Unit cur, nxt; int ui = 0;
    if (!S.next(0, cur)) return;
    f32x4 acc[2][2][4][2];
#pragma unroll
    for (int a = 0; a < 2; ++a)
#pragma unroll
        for (int b = 0; b < 2; ++b)
#pragma unroll
            for (int m = 0; m < 4; ++m)
#pragma unroll
                for (int n = 0; n < 2; ++n) acc[a][b][m][n] = (f32x4){0.f, 0.f, 0.f, 0.f};
    bf16x8 At[4][2], B0[2][2], B1[2][2];
    const char* cA = (const char*)g.A + (size_t)cur.pm * tstep; const char* cB = (const char*)g.Bt + (size_t)cur.pn * tstep;
    S.a_ready(cur);
    if constexpr (SP2) {
        PG8_STAGE(PG8_SB(0, 0), cB, voffB); PG8_STAGE(PG8_SB(0, 1), cB + hstep, voffB); PG8_STAGE(PG8_SA(0, 0), cA, voffA); PG8_STAGE(PG8_SA(0, 1), cA + hstep, voffA);
        if (wr == 1) PG8_BAR;
        PG8_WAIT_V(2); PG8_BAR;
        PG8_STAGE(PG8_SB(1, 0), cB + kstep, voffB); PG8_STAGE(PG8_SA(1, 0), cA + kstep, voffA); PG8_STAGE(PG8_SB(1, 1), cB + hstep + kstep, voffB);
        PG8_WAIT_V(6); PG8_BAR;
    } else {
        PG8_STAGE(PG8_SB(0, 0), cB, voffB); PG8_STAGE(PG8_SA(0, 0), cA, voffA); PG8_STAGE(PG8_SB(0, 1), cB + hstep, voffB); PG8_STAGE(PG8_SA(0, 1), cA + hstep, voffA);
        if (wr == 1) PG8_BAR;
        PG8_WAIT_V(4); PG8_BAR;
        PG8_STAGE(PG8_SB(1, 0), cB + kstep, voffB); PG8_STAGE(PG8_SA(1, 0), cA + kstep, voffA); PG8_STAGE(PG8_SB(1, 1), cB + hstep + kstep, voffB);
        PG8_WAIT_V(6); PG8_BAR;
    }
    for (;;) {
        const bool has_next = S.next(ui + 1, nxt);
        const char* nA = has_next ? (const char*)g.A + (size_t)nxt.pm * tstep : cA; const char* nB = has_next ? (const char*)g.Bt + (size_t)nxt.pn * tstep : cB;
        for (int t = 0; t < nt; t += 2) {
            const bool last = (t == nt - 2);
            const char* a1 = cA + (size_t)(t + 1) * kstep;
            const char* a2 = last ? nA : cA + (size_t)(t + 2) * kstep; const char* b2 = last ? nB : cB + (size_t)(t + 2) * kstep;
            const char* a3 = a2 + kstep; const char* b3 = b2 + kstep;
            if (last && has_next) S.a_ready(nxt);
            if constexpr (SP2) {
            PG8_LDB(B0, 0, 0); PG8_LDB(B1, 0, 1); PG8_SCHED; PG8_LDA(At, 0, 0); PG8_STAGE(PG8_SA(1, 1), a1 + hstep, voffA);
            PG8_WAIT_V(8); PG8_WAIT_L(0); PG8_BAR; PG8_MMA(0, 0, At, B0); PG8_MMA(0, 1, At, B1); PG8_BAR; PG8_SCHED;
            PG8_LDA(At, 0, 1); PG8_STAGE(PG8_SB(0, 0), b2, voffB); PG8_STAGE(PG8_SB(0, 1), b2 + hstep, voffB); PG8_STAGE(PG8_SA(0, 0), a2, voffA);
            PG8_WAIT_V(8); PG8_WAIT_L(0); PG8_BAR; PG8_MMA(1, 0, At, B0); PG8_MMA(1, 1, At, B1); PG8_BAR; PG8_SCHED;
            PG8_LDB(B0, 1, 0); PG8_LDB(B1, 1, 1); PG8_SCHED; PG8_LDA(At, 1, 0); PG8_STAGE(PG8_SA(0, 1), a2 + hstep, voffA);
            PG8_WAIT_V(8); PG8_WAIT_L(0); PG8_BAR; PG8_MMA(0, 0, At, B0); PG8_MMA(0, 1, At, B1); PG8_BAR; PG8_SCHED;
            PG8_LDA(At, 1, 1); PG8_STAGE(PG8_SB(1, 0), b3, voffB); PG8_STAGE(PG8_SB(1, 1), b3 + hstep, voffB); PG8_STAGE(PG8_SA(1, 0), a3, voffA);
            PG8_WAIT_V(8); PG8_WAIT_L(0); PG8_BAR; PG8_MMA(1, 0, At, B0); PG8_MMA(1, 1, At, B1); PG8_BAR; PG8_SCHED;
            } else {
            PG8_LDB(B0, 0, 0); PG8_SCHED; PG8_LDA(At, 0, 0); PG8_STAGE(PG8_SA(1, 1), a1 + hstep, voffA);
            PG8_WAIT_L(8); PG8_BAR; PG8_WAIT_L(0); PG8_MMA(0, 0, At, B0); PG8_BAR; PG8_SCHED;
            PG8_LDB(B1, 0, 1); PG8_STAGE(PG8_SB(0, 0), b2, voffB);
            PG8_BAR; PG8_WAIT_L(0); PG8_MMA(0, 1, At, B1); PG8_BAR;
            PG8_LDA(At, 0, 1); PG8_STAGE(PG8_SA(0, 0), a2, voffA);
            PG8_BAR; PG8_WAIT_L(0); PG8_MMA(1, 0, At, B0); PG8_BAR; PG8_SCHED;
            PG8_STAGE(PG8_SB(0, 1), b2 + hstep, voffB);
            PG8_WAIT_V(6); PG8_BAR; PG8_MMA(1, 1, At, B1); PG8_BAR;
            PG8_LDB(B0, 1, 0); PG8_SCHED; PG8_LDA(At, 1, 0); PG8_STAGE(PG8_SA(0, 1), a2 + hstep, voffA);
            PG8_WAIT_L(8); PG8_BAR; PG8_WAIT_L(0); PG8_MMA(0, 0, At, B0); PG8_BAR; PG8_SCHED;
            PG8_LDB(B1, 1, 1); PG8_STAGE(PG8_SB(1, 0), b3, voffB);
            PG8_BAR; PG8_WAIT_L(0); PG8_MMA(0, 1, At, B1); PG8_BAR;
            PG8_LDA(At, 1, 1); PG8_STAGE(PG8_SA(1, 0), a3, voffA);
            PG8_BAR; PG8_WAIT_L(0); PG8_MMA(1, 0, At, B0); PG8_BAR; PG8_SCHED;
            PG8_STAGE(PG8_SB(1, 1), b3 + hstep, voffB);
            PG8_WAIT_V(6); PG8_BAR; PG8_MMA(1, 1, At, B1); PG8_BAR;
            }
        }
        if constexpr (ALIGN_EPI) { if (wr == 0) PG8_BAR; }
        if constexpr (!Epi::AFTER_DRAIN) { E(acc, cur, wr, wc, fr, fq); S.done(cur); }
        if (!has_next) break;
#pragma unroll
        for (int a = 0; a < 2; ++a)
#pragma unroll
            for (int b = 0; b < 2; ++b)
#pragma unroll
                for (int m = 0; m < 4; ++m)
#pragma unroll
                    for (int n = 0; n < 2; ++n) acc[a][b][m][n] = (f32x4){0.f, 0.f, 0.f, 0.f};
        cur = nxt; cA = nA; cB = nB; ++ui;
        if constexpr (ALIGN_EPI) { if (wr == 1) PG8_BAR; }
    }
    PG8_WAIT_V(0);
    if constexpr (!ALIGN_EPI) { if (wr == 0) PG8_BAR; }
    PG8_BAR;
    if constexpr (Epi::AFTER_DRAIN) { E.fused(acc, cur, wr, wc, fr, fq, lds, wid, lane); S.done(cur); }
#undef PG8_SA
#undef PG8_SB
#undef PG8_STAGE
#undef PG8_LDA
#undef PG8_LDB
#undef PG8_MMA
#undef PG8_WAIT_V
#undef PG8_WAIT_L
#undef PG8_BAR
#undef PG8_SCHED
}
}

constexpr int BATCH = 4, SEQ = 4096, DM = 1024, DEPTH = 2, HD = 64, NH = 8, AW = 512, LW = 512, NLB = 8, INW = 2560, FF = 4096;
constexpr int M = BATCH * SEQ;
constexpr int NWAVES = 8;
constexpr float LOG2E = 1.4426950408889634f, LN2 = 0.6931471805599453f, RMS_EPS = pg8::RMS_EPS;
constexpr int LCH = 64, NCH = SEQ / LCH;
#define LAS __attribute__((address_space(3)))
typedef unsigned short bf16;
typedef unsigned u32x4 __attribute__((ext_vector_type(4)));
typedef unsigned u32x2 __attribute__((ext_vector_type(2)));
typedef float f32x4 __attribute__((ext_vector_type(4)));
typedef float f32x2 __attribute__((ext_vector_type(2)));
typedef float f32x16 __attribute__((ext_vector_type(16)));
typedef short bf16x8 __attribute__((ext_vector_type(8)));
typedef __bf16 bf16x2_t __attribute__((ext_vector_type(2)));

constexpr size_t MiB = 1u << 20;
constexpr size_t WS_SSQA = 0, WS_SSQB = 1 * MiB, WS_SUMM = 2 * MiB, WS_GATE = 3 * MiB, WS_W = 4 * MiB;
constexpr size_t W_IN_OFF = 0, W_OUT_OFF = 5 * MiB, W_UP_OFF = 7 * MiB, W_DOWN_OFF = 15 * MiB, W_LAYER = 23 * MiB;
constexpr size_t WS_BAR = 3 * MiB + 512 * 1024;
constexpr size_t WS_XB = 50 * MiB, WS_H = 82 * MiB, WS_PROJ = 82 * MiB, WS_MIX = 162 * MiB, WS_AB = 210 * MiB, WS_LO1 = 210 * MiB, WS_END = 242 * MiB;
constexpr int LRU_WAVE_LDS = 16896;
constexpr int LDS_MISC = 8 * LRU_WAVE_LDS, LDS_BYTES = LDS_MISC + 1024;

__device__ __forceinline__ unsigned pk_bf16(float lo, float hi) { f32x2 v = {lo, hi}; bf16x2_t b = __builtin_convertvector(v, bf16x2_t); return __builtin_bit_cast(unsigned, b); }
__device__ __forceinline__ float bf_lo(unsigned u) { return __uint_as_float(u << 16); }
__device__ __forceinline__ float bf_hi(unsigned u) { return __uint_as_float(u & 0xffff0000u); }
__device__ __forceinline__ float bf2f(bf16 h) { return __uint_as_float((unsigned)h << 16); }
__device__ __forceinline__ float xhalf(float v) {
    const auto r = __builtin_amdgcn_permlane32_swap(__float_as_uint(v), __float_as_uint(v), false, false);
    return __uint_as_float((threadIdx.x & 32) ? r[0] : r[1]);
}
__device__ __forceinline__ float wave_sum(float v) {
#pragma unroll
    for (int o = 1; o < 64; o <<= 1) v += __shfl_xor(v, o);
    return v;
}
#define LDS_WAIT() asm volatile("s_waitcnt lgkmcnt(0)" ::: "memory")

struct In { const float *x, *norm1_g, *w_in, *conv_w, *conv_b, *w_rg, *b_rg, *w_ig, *b_ig, *lam, *qg, *kg, *w_out, *norm2_g, *w_up, *w_down; };
struct TItem { const float* W; const float* g; bf16* WT; int K, N, item; };
constexpr int I_IN = (DM / 64) * (INW / 32), I_OUT = (DM / 64) * (DM / 32), I_UP = (DM / 64) * (FF / 32), I_DN = (FF / 64) * (DM / 32), I_G = 2 * NLB * 2;
constexpr int I_LAYERW = I_IN + I_OUT + I_UP + I_DN;
__device__ __forceinline__ TItem resolve_w(const In& I, unsigned char* ws, int l, int r) {
    unsigned char* wb = ws + WS_W + (size_t)l * W_LAYER; TItem t;
    if (r < I_IN) { t.W = I.w_in + (size_t)l * DM * INW; t.g = I.norm1_g + l * DM; t.WT = (bf16*)(wb + W_IN_OFF); t.K = DM; t.N = INW; t.item = r; return t; } r -= I_IN;
    if (r < I_OUT) { t.W = I.w_out + (size_t)l * DM * DM; t.g = nullptr; t.WT = (bf16*)(wb + W_OUT_OFF); t.K = DM; t.N = DM; t.item = r; return t; } r -= I_OUT;
    if (r < I_UP) { t.W = I.w_up + (size_t)l * DM * FF; t.g = I.norm2_g + l * DM; t.WT = (bf16*)(wb + W_UP_OFF); t.K = DM; t.N = FF; t.item = r; return t; } r -= I_UP;
    t.W = I.w_down + (size_t)l * FF * DM; t.g = nullptr; t.WT = (bf16*)(wb + W_DOWN_OFF); t.K = FF; t.N = DM; t.item = r; return t;
}
__device__ __forceinline__ TItem resolve_gate(const In& I, unsigned char* ws, int r) {
    const int l = r / I_G, q = r % I_G, mat = q >> 1, gate = mat / NLB, nb = mat % NLB; TItem t;
    t.W = (gate ? I.w_ig : I.w_rg) + ((size_t)l * NLB + nb) * 4096; t.g = nullptr; t.WT = (bf16*)(ws + WS_GATE) + ((size_t)(l * 2 + gate) * NLB + nb) * 4096; t.K = 64; t.N = 64; t.item = q & 1; return t;
}
__device__ __forceinline__ void titem_load(const TItem& t, int lane, float (&v)[32]) {
    const int nblk = t.N / 32, kb = t.item / nblk, nb = t.item % nblk, k0 = 64 * kb, n0 = 32 * nb;
    const float* src = t.W + (size_t)(k0 + (lane >> 5)) * t.N + n0 + (lane & 31);
#pragma unroll
    for (int i = 0; i < 32; ++i) v[i] = src[(size_t)(2 * i) * t.N];
}
__device__ __forceinline__ void titem_finish(const TItem& t, LAS float* scr, int lane, const float (&v)[32]) {
    const int nblk = t.N / 32, kb = t.item / nblk, nb = t.item % nblk, k0 = 64 * kb, n0 = 32 * nb;
#pragma unroll
    for (int i = 0; i < 32; ++i) { const int kk = 2 * i + (lane >> 5); const float gv = t.g ? t.g[k0 + kk] : 1.0f; scr[kk * 33 + (lane & 31)] = v[i] * gv; }
    LDS_WAIT();
    const int c = lane & 7;
#pragma unroll
    for (int j = 0; j < 4; ++j) { const int n = (lane >> 3) + 8 * j; const LAS float* s = scr + (8 * c) * 33 + n;
        u32x4 o; o.x = pk_bf16(s[0 * 33], s[1 * 33]); o.y = pk_bf16(s[2 * 33], s[3 * 33]); o.z = pk_bf16(s[4 * 33], s[5 * 33]); o.w = pk_bf16(s[6 * 33], s[7 * 33]);
        *(u32x4*)(t.WT + (size_t)(n0 + n) * t.K + k0 + 8 * c) = o; }
    LDS_WAIT();
}
__device__ __forceinline__ void convert_w_range(const In& I, unsigned char* ws, LAS float* scr, int l, int lo, int hi, int w, int NW, int lane) {
    int it = lo + w; if (it >= hi) return;
    TItem cur = resolve_w(I, ws, l, it); float va[32]; titem_load(cur, lane, va);
    for (;;) {
        const int nx = it + NW; const bool more = nx < hi;
        TItem nxt = cur; float vb[32];
        if (more) { nxt = resolve_w(I, ws, l, nx); titem_load(nxt, lane, vb); }
        titem_finish(cur, scr, lane, va);
        if (!more) break;
        cur = nxt; it = nx;
#pragma unroll
        for (int i = 0; i < 32; ++i) va[i] = vb[i];
    }
}

__device__ __forceinline__ void p0_prologue(const In& I, unsigned char* ws, LAS unsigned char* lds, int gw, int NGW, int wave, int lane) {
    LAS float* scr = (LAS float*)(lds + wave * LRU_WAVE_LDS);
    bf16* XB = (bf16*)(ws + WS_XB); float* SSQ = (float*)(ws + WS_SSQA);
    for (int m = 2 * gw; m < M; m += 2 * NGW) {
        f32x4 v[2][4];
#pragma unroll
        for (int r = 0; r < 2; ++r)
#pragma unroll
            for (int j = 0; j < 4; ++j) v[r][j] = ((const f32x4*)(I.x + (size_t)(m + r) * DM) + lane)[64 * j];
#pragma unroll
        for (int r = 0; r < 2; ++r) { float s = 0.f; unsigned long long* o8 = (unsigned long long*)(XB + (size_t)(m + r) * DM) + lane;
#pragma unroll
            for (int j = 0; j < 4; ++j) { const f32x4 x = v[r][j]; s += (x[0] * x[0] + x[1] * x[1]) + (x[2] * x[2] + x[3] * x[3]);
                o8[64 * j] = (unsigned long long)pk_bf16(x[0], x[1]) | ((unsigned long long)pk_bf16(x[2], x[3]) << 32); }
            s = wave_sum(s);
            if (lane < 16) SSQ[(size_t)(m + r) * 16 + lane] = lane == 0 ? s : 0.f; }
    }
    convert_w_range(I, ws, scr, 0, 0, I_IN, gw, NGW, lane);
    for (int r = gw; r < DEPTH * I_G; r += NGW) { const TItem t = resolve_gate(I, ws, r); float v[32]; titem_load(t, lane, v); titem_finish(t, scr, lane, v); }
}

struct LruW { const float *conv_w, *conv_b, *b_rg, *b_ig, *lam; const bf16 *wrgT, *wigT; };
__device__ __forceinline__ float sigmoidf_(float x) { return __builtin_amdgcn_rcpf(1.0f + __builtin_amdgcn_exp2f(-x * LOG2E)); }
template <bool PASS_B>
__device__ __forceinline__ void lru_unit(LAS unsigned char* wl, const bf16* PROJ, bf16* MIX, f32x2* SUMM, unsigned* ABbuf, const LruW& w, int b, int j, int n, int lane) {
    const int l32 = lane & 31, hi = lane >> 5;
    LAS float* pre = (LAS float*)wl; LAS bf16* xcb = (LAS bf16*)wl; LAS bf16* xlt = (LAS bf16*)(wl + 8192); LAS bf16* glt = (LAS bf16*)(wl + 12800);
    bf16x8 br[2][4], bi[2][4];
    { const bf16* WR = w.wrgT + n * 4096; const bf16* WI = w.wigT + n * 4096;
#pragma unroll
      for (int nt = 0; nt < 2; ++nt)
#pragma unroll
        for (int ks = 0; ks < 4; ++ks) { br[nt][ks] = *(const bf16x8*)(WR + (32 * nt + l32) * 64 + 16 * ks + 8 * hi); bi[nt][ks] = *(const bf16x8*)(WI + (32 * nt + l32) * 64 + 16 * ks + 8 * hi); } }
    const int c = 64 * n + lane;
    unsigned* AB = ABbuf + (size_t)b * SEQ * LW + c;
    const float cw0 = w.conv_w[0 * LW + c], cw1 = w.conv_w[1 * LW + c], cw2 = w.conv_w[2 * LW + c], cw3 = w.conv_w[3 * LW + c], cb = w.conv_b[c];
    const float brg = w.b_rg[c], big = w.b_ig[c];
    float spl; { const float nl = -w.lam[c]; spl = fmaxf(nl, 0.f) + log1pf(__expf(-fabsf(nl))); }
    const float cA = -8.0f * spl * LOG2E, nbrg = -brg * LOG2E, nbig = -big * LOG2E;
    constexpr float GELU_K = -2.0f * LOG2E * 0.7978845608028654f;
    float h = 0.f, P = 1.f;
    if (PASS_B) {
        const f32x2* sp = SUMM + (size_t)b * NCH * LW + c; int jj = 0;
        for (; jj + 8 <= j; jj += 8) { f32x2 sv[8];
#pragma unroll
            for (int q = 0; q < 8; ++q) sv[q] = sp[(size_t)(jj + q) * LW];
#pragma unroll
            for (int q = 0; q < 8; ++q) h = sv[q][0] * h + sv[q][1]; }
        for (; jj < j; ++jj) { const f32x2 sv = sp[(size_t)jj * LW]; h = sv[0] * h + sv[1]; }
    }
    const int s0 = j * LCH;
    const bf16* prow = PROJ + (size_t)b * SEQ * INW;
    const int lr = lane >> 3, lc = lane & 7;
    u32x4 xnext[5];
#pragma unroll
    for (int i = 0; i < 5; ++i) { const int tr = 8 * i + lr; const int sx = s0 - 3 + tr; xnext[i] = (u32x4){0u, 0u, 0u, 0u};
        if (tr < 35 && sx >= 0) xnext[i] = *(const u32x4*)(prow + (size_t)sx * INW + 3 * AW + 64 * n + 8 * lc); }
    for (int tt = 0; tt < LCH / 32; ++tt) {
        const int st = s0 + 32 * tt;
        { u32x4 xr[5]; u32x4 gr[4];
#pragma unroll
          for (int i = 0; i < 5; ++i) xr[i] = xnext[i];
          if (PASS_B) {
#pragma unroll
              for (int i = 0; i < 4; ++i) gr[i] = *(const u32x4*)(prow + (size_t)(st + 8 * i + lr) * INW + 3 * AW + LW + 64 * n + 8 * lc); }
#pragma unroll
          for (int i = 0; i < 5; ++i) { const int tr = 8 * i + lr; if (tr < 35) *(LAS u32x4*)(xlt + tr * 64 + 8 * lc) = xr[i]; }
          if (PASS_B) {
#pragma unroll
              for (int i = 0; i < 4; ++i) *(LAS u32x4*)(glt + (8 * i + lr) * 64 + 8 * lc) = gr[i]; }
        }
        LDS_WAIT();
        float xcv[32];
        { float a3 = bf2f(xlt[0 * 64 + lane]), a2 = bf2f(xlt[1 * 64 + lane]), a1 = bf2f(xlt[2 * 64 + lane]);
#pragma unroll
          for (int t = 0; t < 32; ++t) { const float xv = bf2f(xlt[(t + 3) * 64 + lane]); xcv[t] = cb + cw0 * a3 + cw1 * a2 + cw2 * a1 + cw3 * xv; a3 = a2; a2 = a1; a1 = xv;
              xcb[t * 72 + lane] = (bf16)(pk_bf16(xcv[t], 0.f) & 0xffffu); if ((t & 7) == 7) asm volatile("" ::: "memory"); } }
        LDS_WAIT();
        bf16x8 af[4];
#pragma unroll
        for (int ks = 0; ks < 4; ++ks) af[ks] = *(const LAS bf16x8*)(xcb + l32 * 72 + 16 * ks + 8 * hi);
        LDS_WAIT();
        f32x16 pr0, pr1, pi0, pi1;
        { f32x16 ar[2], ai[2];
#pragma unroll
          for (int nt = 0; nt < 2; ++nt) {
#pragma unroll
            for (int e = 0; e < 16; ++e) { ar[nt][e] = 0.f; ai[nt][e] = 0.f; }
#pragma unroll
            for (int ks = 0; ks < 4; ++ks) { ar[nt] = __builtin_amdgcn_mfma_f32_32x32x16_bf16(af[ks], br[nt][ks], ar[nt], 0, 0, 0); ai[nt] = __builtin_amdgcn_mfma_f32_32x32x16_bf16(af[ks], bi[nt][ks], ai[nt], 0, 0, 0); } }
#pragma unroll
          for (int e = 0; e < 16; ++e) {
              const auto sr = __builtin_amdgcn_permlane32_swap(__float_as_uint(ar[0][e]), __float_as_uint(ar[1][e]), false, false);
              pr0[e] = __uint_as_float(sr[0]); pr1[e] = __uint_as_float(sr[1]);
              const auto si = __builtin_amdgcn_permlane32_swap(__float_as_uint(ai[0][e]), __float_as_uint(ai[1][e]), false, false);
              pi0[e] = __uint_as_float(si[0]); pi1[e] = __uint_as_float(si[1]); } }
        if (tt + 1 < LCH / 32) {
#pragma unroll
            for (int i = 0; i < 5; ++i) { const int tr = 8 * i + lr; const int sx = st + 32 - 3 + tr; xnext[i] = (u32x4){0u, 0u, 0u, 0u};
                if (tr < 35 && sx >= 0) xnext[i] = *(const u32x4*)(prow + (size_t)sx * INW + 3 * AW + 64 * n + 8 * lc); } }
#pragma unroll
        for (int t = 0; t < 32; ++t) {
            if ((t & 3) == 0) asm volatile("" ::: "memory");
            const float xc = xcv[t];
            const int te = (t & 3) + 4 * (t >> 3); const float prr = ((t >> 2) & 1) ? pr1[te] : pr0[te], pri = ((t >> 2) & 1) ? pi1[te] : pi0[te];
            const float r = __builtin_amdgcn_rcpf(1.0f + __builtin_amdgcn_exp2f(__builtin_fmaf(prr, -LOG2E, nbrg)));
            const float ig = __builtin_amdgcn_rcpf(1.0f + __builtin_amdgcn_exp2f(__builtin_fmaf(pri, -LOG2E, nbig)));
            const float a0 = __builtin_amdgcn_exp2f(cA * r); const float mult = __builtin_amdgcn_sqrtf(__builtin_fmaf(-a0, a0, 1.0f));
            const float bt = mult * (ig * xc); const float a = a0;
            if (!PASS_B) AB[(size_t)(st + t) * LW] = pk_bf16(cA * r, bt);
            h = __builtin_fmaf(a, h, bt);
            if (PASS_B) { const float gl = bf2f(glt[t * 64 + lane]);
                const float v = __builtin_fmaf(gl * gl, GELU_K * 0.044715f, GELU_K) * gl;
                const float ge = gl * __builtin_amdgcn_rcpf(1.0f + __builtin_amdgcn_exp2f(v));
                glt[t * 64 + lane] = (bf16)(pk_bf16(h * ge, 0.f) & 0xffffu); }
            else P *= a;
        }
        LDS_WAIT();
        if (PASS_B) {
#pragma unroll
            for (int i = 0; i < 4; ++i) { const u32x4 y = *(const LAS u32x4*)(glt + (8 * i + lr) * 64 + 8 * lc);
                *(u32x4*)(MIX + ((size_t)b * SEQ + st + 8 * i + lr) * DM + AW + 64 * n + 8 * lc) = y; }
            LDS_WAIT();
        }
    }
    if (!PASS_B) { f32x2 sv = {P, h}; SUMM[((size_t)b * NCH + j) * LW + c] = sv; }
}

__device__ __forceinline__ void lru_apply_unit(LAS unsigned char* wl, const bf16* PROJ, bf16* MIX, const f32x2* SUMM, const unsigned* ABbuf, int b, int j, int n, int lane) {
    LAS bf16* glt = (LAS bf16*)(wl + 8192);
    const int c = 64 * n + lane;
    constexpr float GELU_K = -2.0f * LOG2E * 0.7978845608028654f;
    const int s0 = j * LCH;
    const bf16* prow = PROJ + (size_t)b * SEQ * INW;
    const unsigned* AB = ABbuf + (size_t)b * SEQ * LW + c;
    const int lr = lane >> 3, lc = lane & 7;
    unsigned ab[2][32]; u32x4 gr[2][4];
#pragma unroll
    for (int tt = 0; tt < 2; ++tt) {
#pragma unroll
        for (int i = 0; i < 4; ++i) gr[tt][i] = *(const u32x4*)(prow + (size_t)(s0 + 32 * tt + 8 * i + lr) * INW + 3 * AW + LW + 64 * n + 8 * lc);
#pragma unroll
        for (int t = 0; t < 32; ++t) ab[tt][t] = AB[(size_t)(s0 + 32 * tt + t) * LW]; }
    float h = 0.f;
    { const f32x2* sp = SUMM + (size_t)b * NCH * LW + c; int jj = 0;
      for (; jj < j; jj += 16) { f32x2 sv[16];
#pragma unroll
          for (int q = 0; q < 16; ++q) { const int jq = jj + q < j ? jj + q : j - 1; sv[q] = sp[(size_t)jq * LW]; }
#pragma unroll
          for (int q = 0; q < 16; ++q) { const bool on = jj + q < j; h = (on ? sv[q][0] : 1.0f) * h + (on ? sv[q][1] : 0.f); } } }
#pragma unroll
    for (int tt = 0; tt < 2; ++tt)
#pragma unroll
        for (int i = 0; i < 4; ++i) *(LAS u32x4*)(glt + tt * 2048 + (8 * i + lr) * 64 + 8 * lc) = gr[tt][i];
    LDS_WAIT();
#pragma unroll
    for (int tt = 0; tt < 2; ++tt) {
#pragma unroll
        for (int t = 0; t < 32; ++t) {
            const float a = __builtin_amdgcn_exp2f(bf_lo(ab[tt][t]));
            h = __builtin_fmaf(a, h, bf_hi(ab[tt][t]));
            const float gl = bf2f(glt[tt * 2048 + t * 64 + lane]);
            const float v = __builtin_fmaf(gl * gl, GELU_K * 0.044715f, GELU_K) * gl;
            const float ge = gl * __builtin_amdgcn_rcpf(1.0f + __builtin_amdgcn_exp2f(v));
            glt[tt * 2048 + t * 64 + lane] = (bf16)(pk_bf16(h * ge, 0.f) & 0xffffu);
        }
    }
    LDS_WAIT();
#pragma unroll
    for (int tt = 0; tt < 2; ++tt)
#pragma unroll
        for (int i = 0; i < 4; ++i) { const u32x4 y = *(const LAS u32x4*)(glt + tt * 2048 + (8 * i + lr) * 64 + 8 * lc);
            *(u32x4*)(MIX + ((size_t)b * SEQ + s0 + 32 * tt + 8 * i + lr) * DM + AW + 64 * n + 8 * lc) = y; }
    LDS_WAIT();
}

constexpr float STICK_EXIT = 2.3283064365386963e-10f;
__device__ __forceinline__ void load_raw_frag(const bf16* p  , u32x4 (&raw)[4]) {
#pragma unroll
    for (int ks = 0; ks < 4; ++ks) raw[ks] = *(const u32x4*)(p + 16 * ks);
}
__device__ __forceinline__ void norm_frag(const u32x4 (&raw)[4], const float* g, int hi, float scale, bf16x8 (&f)[4]) {
    float ss = 0.f;
#pragma unroll
    for (int ks = 0; ks < 4; ++ks)
#pragma unroll
        for (int e = 0; e < 4; ++e) { const float a = bf_lo(raw[ks][e]), b2 = bf_hi(raw[ks][e]); ss += a * a + b2 * b2; }
    ss += xhalf(ss);
    const float rs = __builtin_amdgcn_rsqf(ss * (1.0f / 64.0f) + RMS_EPS) * scale;
#pragma unroll
    for (int ks = 0; ks < 4; ++ks) { const f32x4 g0 = *(const f32x4*)(g + 16 * ks + 8 * hi), g1 = *(const f32x4*)(g + 16 * ks + 8 * hi + 4); u32x4 o;
        o[0] = pk_bf16(bf_lo(raw[ks][0]) * rs * g0[0], bf_hi(raw[ks][0]) * rs * g0[1]); o[1] = pk_bf16(bf_lo(raw[ks][1]) * rs * g0[2], bf_hi(raw[ks][1]) * rs * g0[3]);
        o[2] = pk_bf16(bf_lo(raw[ks][2]) * rs * g1[0], bf_hi(raw[ks][2]) * rs * g1[1]); o[3] = pk_bf16(bf_lo(raw[ks][3]) * rs * g1[2], bf_hi(raw[ks][3]) * rs * g1[3]);
        f[ks] = __builtin_bit_cast(bf16x8, o); }
}
__device__ __forceinline__ void load_v_raw(const bf16* vtile  , int lane, u32x4 (&vr)[4]) {
#pragma unroll
    for (int i = 0; i < 4; ++i) vr[i] = *(const u32x4*)(vtile + (size_t)(8 * i + (lane >> 3)) * INW + 8 * (lane & 7));
}
__device__ __forceinline__ void store_v_lds(LAS bf16* vb, int lane, const u32x4 (&vr)[4]) {
#pragma unroll
    for (int i = 0; i < 4; ++i) *(LAS u32x4*)(vb + (8 * i + (lane >> 3)) * 64 + 8 * (lane & 7)) = vr[i];
}
__device__ __forceinline__ void read_v_frag(const LAS bf16* vb, int l32, int hi, bf16x8 (&vf)[2][2]) {
    const LAS bf16* vp = vb + 4 * hi * 64 + l32;
#pragma unroll
    for (int st = 0; st < 2; ++st)
#pragma unroll
        for (int i = 0; i < 8; ++i) { const int ko = 16 * st + 8 * (i >> 2) + (i & 3);
            vf[0][st][i] = (short)vp[ko * 64]; vf[1][st][i] = (short)vp[ko * 64 + 32]; }
}
__device__ __forceinline__ void attn_unit(LAS unsigned char* wl, const bf16* PROJ, bf16* MIX, const float* gq, const float* gk, int b, int h, int qt, int lane) {
    const int l32 = lane & 31, hi = lane >> 5;
    LAS bf16* vbuf = (LAS bf16*)wl;
    const bf16* prow = PROJ + (size_t)b * SEQ * INW;
    const int q0 = qt * 32;
    u32x4 qraw[4], kraw[4], vraw[4];
    load_raw_frag(prow + (size_t)(q0 + l32) * INW + h * HD + 8 * hi, qraw);
    load_raw_frag(prow + (size_t)(q0 + l32) * INW + AW + h * HD + 8 * hi, kraw);
    load_v_raw(prow + (size_t)q0 * INW + 2 * AW + h * HD, lane, vraw);
    bf16x8 qf[4];
    norm_frag(qraw, gq, hi, 0.125f * LOG2E, qf);
    store_v_lds(vbuf + (qt & 1) * 2048, lane, vraw);
    f32x16 O0, O1;
#pragma unroll
    for (int e = 0; e < 16; ++e) { O0[e] = 0.f; O1[e] = 0.f; }
    float R = 1.0f;
    for (int kt = qt; ; --kt) {
        const int kn = (kt > 0 ? kt - 1 : 0) * 32;
        u32x4 kraw_n[4];
        load_raw_frag(prow + (size_t)(kn + l32) * INW + AW + h * HD + 8 * hi, kraw_n);
        load_v_raw(prow + (size_t)kn * INW + 2 * AW + h * HD, lane, vraw);
        bf16x8 kf[4];
        norm_frag(kraw, gk, hi, 1.0f, kf);
        f32x16 S;
#pragma unroll
        for (int e = 0; e < 16; ++e) S[e] = 0.f;
#pragma unroll
        for (int ks = 0; ks < 4; ++ks) S = __builtin_amdgcn_mfma_f32_32x32x16_bf16(kf[ks], qf[ks], S, 0, 0, 0);
        LDS_WAIT();
        bf16x8 vf[2][2];
        read_v_frag(vbuf + (kt & 1) * 2048, l32, hi, vf);
        const bool diag = (kt == qt);
        float inv[16], bet[16], gp[4];
#pragma unroll
        for (int g = 0; g < 4; ++g) { float acc = 1.f;
#pragma unroll
            for (int e2 = 0; e2 < 4; ++e2) { const int e = 4 * g + e2;
                const float ez = __builtin_amdgcn_exp2f(fminf(S[e], 80.0f));
                const float iv = __builtin_amdgcn_rcpf(1.0f + ez);
                const bool masked = diag && ((e2 + 8 * g + 4 * hi) >= l32);
                inv[e] = masked ? 1.0f : iv; bet[e] = masked ? 0.f : ez * iv; acc *= inv[e]; }
            gp[g] = acc; }
        float ps[4];
#pragma unroll
        for (int g = 0; g < 4; ++g) ps[g] = xhalf(gp[g]);
        float right = R; float wv[16];
#pragma unroll
        for (int g = 3; g >= 0; --g) {
            float run = right * (hi == 0 ? ps[g] : 1.0f);
#pragma unroll
            for (int e2 = 3; e2 >= 0; --e2) { const int e = 4 * g + e2; wv[e] = bet[e] * run; run *= inv[e]; }
            right *= gp[g] * ps[g];
        }
        R = right;
        bf16x8 wf[2];
#pragma unroll
        for (int st = 0; st < 2; ++st) { u32x4 o;
#pragma unroll
            for (int e = 0; e < 4; ++e) o[e] = pk_bf16(wv[8 * st + 2 * e], wv[8 * st + 2 * e + 1]);
            wf[st] = __builtin_bit_cast(bf16x8, o); }
#pragma unroll
        for (int st = 0; st < 2; ++st) { O0 = __builtin_amdgcn_mfma_f32_32x32x16_bf16(vf[0][st], wf[st], O0, 0, 0, 0); O1 = __builtin_amdgcn_mfma_f32_32x32x16_bf16(vf[1][st], wf[st], O1, 0, 0, 0); }
        if (kt == 0 || (!diag && __all(R < STICK_EXIT))) break;
#pragma unroll
        for (int ks = 0; ks < 4; ++ks) kraw[ks] = kraw_n[ks];
        store_v_lds(vbuf + ((kt - 1) & 1) * 2048, lane, vraw);
    }
    bf16* orow = MIX + ((size_t)b * SEQ + q0 + l32) * DM + h * HD;
#pragma unroll
    for (int g = 0; g < 4; ++g) { u32x2 a, c2; a[0] = pk_bf16(O0[4 * g], O0[4 * g + 1]); a[1] = pk_bf16(O0[4 * g + 2], O0[4 * g + 3]); c2[0] = pk_bf16(O1[4 * g], O1[4 * g + 1]); c2[1] = pk_bf16(O1[4 * g + 2], O1[4 * g + 3]);
        *(u32x2*)(orow + 8 * g + 4 * hi) = a; *(u32x2*)(orow + 32 + 8 * g + 4 * hi) = c2; }
    LDS_WAIT();
}

#define XB_TMO      128
#define XB_XCNT(j)  (256  + 64 * (j))
#define XB_XSUB(j)  (1280 + 64 * (j))
#define XB_XGEN(j)  (2304 + 64 * (j))
#define XB_TOP      3328
#define XB_TOPGEN   3392
#define XCD_BAR_WORDS 3456
#define XB_SPIN_CAP (1u << 18)

__device__ __forceinline__ unsigned xb_ld(unsigned* p)              { return __hip_atomic_load(p, __ATOMIC_RELAXED, __HIP_MEMORY_SCOPE_AGENT); }
__device__ __forceinline__ unsigned xb_add(unsigned* p, unsigned v) { return __hip_atomic_fetch_add(p, v, __ATOMIC_RELAXED, __HIP_MEMORY_SCOPE_AGENT); }
__device__ __forceinline__ unsigned xb_xcc_id() { return (unsigned)__builtin_amdgcn_s_getreg((3 << 11) | 20) & 0xFu; }
#define XB_SPIN(cond, bar) do { unsigned _sp = 0; while (cond) { __builtin_amdgcn_s_sleep(1); \
    if ((++_sp & 255u) == 0u) { if (xb_ld(&(bar)[XB_TMO])) break; if (_sp > XB_SPIN_CAP) { atomicAdd(&(bar)[XB_TMO], 1u); break; } } } } while (0)

struct XcdBarrier {
    unsigned* bar; unsigned x;
    volatile LAS unsigned* st;
};

__device__ __forceinline__ XcdBarrier xcd_barrier_post(unsigned* bar, volatile LAS unsigned* st) {
    XcdBarrier b; b.bar = bar; b.x = xb_xcc_id(); b.st = st;
    if (threadIdx.x == 0) (void)xb_add(&bar[XB_XCNT(b.x)], 1u);
    return b;
}
__device__ __forceinline__ void xcd_barrier_complete(unsigned* bar, unsigned x, unsigned& nloc, unsigned& nx) {
    const unsigned G = gridDim.x * gridDim.y * gridDim.z;
    unsigned sum, cnt, mine, sp = 0u;
    for (;;) {
        sum = 0u; cnt = 0u; mine = 0u;
#pragma unroll
        for (unsigned j = 0; j < 16; ++j) { const unsigned c = xb_ld(&bar[XB_XCNT(j)]); sum += c; cnt += (c > 0u) ? 1u : 0u; mine = (j == x) ? c : mine; }
        if (sum == G) break;
        __builtin_amdgcn_s_sleep(1);
        if ((++sp & 255u) == 0u) { if (xb_ld(&bar[XB_TMO])) break; if (sp > XB_SPIN_CAP) { atomicAdd(&bar[XB_TMO], 1u); break; } }
    }
    nloc = mine > 0u ? mine : 1u; nx = cnt > 0u ? cnt : 1u;
}

__device__ __forceinline__ void xcd_barrier(const XcdBarrier& b) {
    asm volatile("s_waitcnt vmcnt(0)" ::: "memory");
    __syncthreads();
    if (threadIdx.x == 0) {
        unsigned* bar = b.bar;
        __builtin_amdgcn_s_waitcnt(0);
        unsigned nloc = b.st[0], nx = b.st[1];
        if (nloc == 0u) { xcd_barrier_complete(bar, b.x, nloc, nx); b.st[0] = nloc; b.st[1] = nx; }
        const unsigned old = xb_add(&bar[XB_XSUB(b.x)], 1u);
        const unsigned gen = old / nloc;
        if (old + 1u == (gen + 1u) * nloc) {
            __builtin_amdgcn_fence(__ATOMIC_RELEASE, "agent");
            asm volatile("s_waitcnt vmcnt(0)" ::: "memory");
            const unsigned og = xb_add(&bar[XB_TOP], 1u);
            const unsigned tg = og / nx;
            if (og + 1u == (tg + 1u) * nx) xb_add(&bar[XB_TOPGEN], 1u);
            else XB_SPIN(xb_ld(&bar[XB_TOPGEN]) == tg, bar);
            __builtin_amdgcn_fence(__ATOMIC_ACQUIRE, "agent");
            xb_add(&bar[XB_XGEN(b.x)], 1u);
            asm volatile("s_waitcnt vmcnt(0)" ::: "memory");
        } else {
            XB_SPIN(xb_ld(&bar[XB_XGEN(b.x)]) == gen, bar);
            __builtin_amdgcn_fence(__ATOMIC_ACQUIRE, "agent");
            asm volatile("s_waitcnt vmcnt(0)" ::: "memory");
        }
    }
    __syncthreads();
}

__device__ __forceinline__ void xcd_split_arrive(unsigned* bar2, const XcdBarrier& b) {
    asm volatile("s_waitcnt vmcnt(0)" ::: "memory");
    __syncthreads();
    if (threadIdx.x == 0) {
        unsigned nloc = b.st[0];
        if (nloc == 0u) { unsigned nx; xcd_barrier_complete(b.bar, b.x, nloc, nx); b.st[0] = nloc; b.st[1] = nx; }
        const unsigned old = xb_add(&bar2[XB_XSUB(b.x)], 1u);
        if ((old + 1u) % nloc == 0u) {
            __builtin_amdgcn_fence(__ATOMIC_RELEASE, "agent");
            asm volatile("s_waitcnt vmcnt(0)" ::: "memory");
            (void)xb_add(&bar2[XB_TOP], 1u);
        }
    }
}
__device__ __forceinline__ void xcd_split_wait(unsigned* bar2, const XcdBarrier& b, unsigned round) {
    if (threadIdx.x == 0) {
        const unsigned want = b.st[1] * round;
        XB_SPIN(xb_ld(&bar2[XB_TOP]) < want, b.bar);
        __builtin_amdgcn_fence(__ATOMIC_ACQUIRE, "agent");
        asm volatile("s_waitcnt vmcnt(0)" ::: "memory");
    }
    __syncthreads();
}

constexpr int CONV_CHUNK = 1536, CONV_TOTAL = DEPTH * I_LAYERW;
__device__ __forceinline__ void convert_chunk(const In& I, unsigned char* ws, LAS float* scr, int k, int w, int NW, int lane) {
    const int glo = I_IN + CONV_CHUNK * k; int ghi = glo + CONV_CHUNK; if (ghi > CONV_TOTAL) ghi = CONV_TOTAL;
    int it = glo + w; if (k < 0 || it >= ghi) return;
    TItem cur = resolve_w(I, ws, it / I_LAYERW, it % I_LAYERW); float va[32]; titem_load(cur, lane, va);
    for (;;) {
        const int nx = it + NW; const bool more = nx < ghi;
        TItem nxt = cur; float vb[32];
        if (more) { nxt = resolve_w(I, ws, nx / I_LAYERW, nx % I_LAYERW); titem_load(nxt, lane, vb); }
        titem_finish(cur, scr, lane, va);
        if (!more) break;
        cur = nxt; it = nx;
#pragma unroll
        for (int i = 0; i < 32; ++i) va[i] = vb[i];
    }
}

#ifndef RESID_LO
#define RESID_LO false
#endif
#ifndef REP_P0
#define REP_P0 1
#endif
#ifndef REP_M1
#define REP_M1 1
#endif
#ifndef REP_M2
#define REP_M2 1
#endif
#ifndef REP_G1
#define REP_G1 1
#endif
#ifndef REP_G3
#define REP_G3 1
#endif
#ifndef REP_G2
#define REP_G2 1
#endif
#ifndef REP_G4
#define REP_G4 1
#endif
struct Params { const float* in[16]; float* out; unsigned char* ws; int ph_lo, ph_hi; };
constexpr int N_PHASES = 1 + 6 * DEPTH;
__global__ void __launch_bounds__(NWAVES * 64, 2) fwd_megakernel(Params p) {
    extern __shared__ __attribute__((aligned(16))) unsigned char lds_raw[];
    LAS unsigned char* lds = (LAS unsigned char*)lds_raw;
    cg::grid_group grid = cg::this_grid();
    const int tid = threadIdx.x, lane0 = tid & 63, wave = __builtin_amdgcn_readfirstlane(tid >> 6);
    const int G = gridDim.x, gw = blockIdx.x * NWAVES + wave, NGW = G * NWAVES;
    In I; I.x = p.in[0]; I.norm1_g = p.in[1]; I.w_in = p.in[2]; I.conv_w = p.in[3]; I.conv_b = p.in[4]; I.w_rg = p.in[5]; I.b_rg = p.in[6]; I.w_ig = p.in[7]; I.b_ig = p.in[8];
    I.lam = p.in[9]; I.qg = p.in[10]; I.kg = p.in[11]; I.w_out = p.in[12]; I.norm2_g = p.in[13]; I.w_up = p.in[14]; I.w_down = p.in[15];
    const int lo = p.ph_lo, hi = p.ph_hi;
#define IN(k) (lo <= (k) && (k) < hi)
#define SEAM(k) do { if (IN(k) && IN((k) + 1)) xcd_barrier(bar); } while (0)
#define LAUNDER(x) asm volatile("" : "+s"(x))
    volatile LAS unsigned* MISC = (volatile LAS unsigned*)(lds + LDS_MISC);
    if (tid < 64) MISC[tid] = 0u;
    __syncthreads();
    XcdBarrier bar; bar.bar = (unsigned*)(p.ws + WS_BAR); bar.x = 0; bar.st = MISC + 8;
    if (hi - lo > 1) bar = xcd_barrier_post((unsigned*)(p.ws + WS_BAR), MISC + 8);
#define SPLIT_SEAM(k, round, chunk) do { if (IN(k)) { unsigned char* ws_ = p.ws; LAUNDER(ws_); int lane_ = lane0; asm volatile("" : "+v"(lane_)); const bool in_ = IN((k) + 1); \
        if (in_) xcd_split_arrive((unsigned*)(ws_ + WS_BAR) + XCD_BAR_WORDS, bar); \
        convert_chunk(I, ws_, (LAS float*)(lds + wave * LRU_WAVE_LDS), (chunk), gw, NGW, lane_); \
        if (in_) xcd_split_wait((unsigned*)(ws_ + WS_BAR) + XCD_BAR_WORDS, bar, (unsigned)(round)); } } while (0)
    if (IN(0)) { for (int rep = 0; rep < REP_P0; ++rep) p0_prologue(I, p.ws, lds, gw, NGW, wave, lane0); }
    SPLIT_SEAM(0, 1, 0);
    for (int l = 0; l < DEPTH; ++l) {
        const int pb = 1 + 6 * l;
        if (IN(pb + 0)) {
            unsigned char* ws = p.ws; LAUNDER(ws);
            pg8::Gemm g{(const bf16*)(ws + WS_XB), (const bf16*)(ws + WS_W + (size_t)l * W_LAYER + W_IN_OFF), M, 4 * AW, DM}; pg8::StaticOrder S; S.init(M, 4 * AW, G, (int)blockIdx.x);
            pg8::EpiScaleBf16<0> E{(bf16*)(ws + WS_PROJ), INW, (const float*)(ws + WS_SSQA)};
            for (int rep = 0; rep < REP_G1; ++rep) pg8::gemm_phase<pg8::EpiScaleBf16<0>, pg8::StaticOrder, true, true>(lds, g, S, E);
            if (IN(pb + 1)) xcd_split_arrive((unsigned*)(ws + WS_BAR) + XCD_BAR_WORDS, bar);
        }
        if (IN(pb + 1)) {
            unsigned char* ws = p.ws; LAUNDER(ws); int lane = lane0; asm volatile("" : "+v"(lane));
            unsigned* bar2 = (unsigned*)(ws + WS_BAR) + XCD_BAR_WORDS;
            const int half = G >> 1; const bool gemm_wg = (int)blockIdx.x < half;
            const bool xmap = (G == 256); const int xb = ((int)blockIdx.x & 7) >> 1, xh = (int)blockIdx.x & 1, lwx = (((int)blockIdx.x >> 3) & 15) * NWAVES + wave;
            if (gemm_wg) {
                pg8::Gemm g{(const bf16*)(ws + WS_XB), (const bf16*)(ws + WS_W + (size_t)l * W_LAYER + W_IN_OFF) + (size_t)4 * AW * DM, M, LW, DM}; pg8::StaticOrder S; S.init(M, LW, half, (int)blockIdx.x);
                pg8::EpiScaleBf16<0> E{(bf16*)(ws + WS_PROJ) + 4 * AW, INW, (const float*)(ws + WS_SSQA)};
                pg8::gemm_phase<pg8::EpiScaleBf16<0>, pg8::StaticOrder, false, true>(lds, g, S, E);
            }
            const bool seam0_inside = IN(pb + 0);
            if (gemm_wg && seam0_inside) xcd_split_wait(bar2, bar, (unsigned)(2 + 6 * l));
            LAUNDER(ws); asm volatile("" : "+v"(lane));
            constexpr int NATT = BATCH * NH * (SEQ / 32), NATT_B = NATT / 2;
            const int nw1 = half * NWAVES, nw2 = (G - half) * NWAVES;
            const int wi = gemm_wg ? gw : gw - nw1;
            if (!gemm_wg) {
                if (seam0_inside) xcd_split_wait(bar2, bar, (unsigned)(2 + 6 * l));
                LruW lw; lw.conv_w = I.conv_w + l * 4 * LW; lw.conv_b = I.conv_b + l * LW; lw.b_rg = I.b_rg + l * LW; lw.b_ig = I.b_ig + l * LW; lw.lam = I.lam + l * LW;
                lw.wrgT = (const bf16*)(ws + WS_GATE) + (size_t)(l * 2 + 0) * NLB * 4096; lw.wigT = (const bf16*)(ws + WS_GATE) + (size_t)(l * 2 + 1) * NLB * 4096;
                for (int u = wi; u < BATCH * NCH * NLB; u += nw2) { int n = u % NLB, j = (u / NLB) % NCH, b = u / (NLB * NCH);
                    if (xmap) { const int lu = lwx + 128 * ((u - wi) / nw2); n = lu % NLB; j = 32 * xh + lu / NLB; b = xb; }
#ifndef NO_LRU
                    lru_unit<false>(lds + wave * LRU_WAVE_LDS, (const bf16*)(ws + WS_PROJ), (bf16*)(ws + WS_MIX), (f32x2*)(ws + WS_SUMM), (unsigned*)(ws + WS_AB), lw, b, j, n, lane);
#endif
                }
                LAUNDER(ws); asm volatile("" : "+v"(lane));
            }
            const bool seam_inside = IN(pb + 2);
            if (seam_inside) xcd_split_arrive(bar2, bar);
            const int ubeg = gemm_wg ? NATT_B + wi : wi, uend = gemm_wg ? NATT : NATT_B, ustep = gemm_wg ? nw1 : nw2;
            for (int u = ubeg; u < uend; u += ustep) { int qt = u % (SEQ / 32), hh = (u / (SEQ / 32)) % NH, b = u / ((SEQ / 32) * NH);
                if (xmap) { const int au = (gemm_wg ? 256 : 0) + lwx + 128 * ((u - ubeg) / ustep); hh = au % NH; qt = 64 * xh + au / NH; b = xb; }
#ifndef NO_ATT
                attn_unit(lds + wave * LRU_WAVE_LDS, (const bf16*)(ws + WS_PROJ), (bf16*)(ws + WS_MIX), I.qg + l * HD, I.kg + l * HD, b, hh, qt, lane);
#endif
            }
            if (seam_inside) xcd_split_wait(bar2, bar, (unsigned)(3 + 6 * l));
        }
        if (IN(pb + 2)) {
            unsigned char* ws = p.ws; LAUNDER(ws); int lane = lane0; asm volatile("" : "+v"(lane));
            const bool xmap = (G == 256); const int xb = ((int)blockIdx.x & 7) >> 1, xh = (int)blockIdx.x & 1, lw2 = ((int)blockIdx.x >> 3) * NWAVES + wave;
            for (int u = gw; u < BATCH * NCH * NLB; u += NGW) { int n = u % NLB, j = (u / NLB) % NCH, b = u / (NLB * NCH);
                if (xmap) { n = lw2 % NLB; j = 32 * xh + lw2 / NLB; b = xb; }
#ifndef NO_LRU
                lru_apply_unit(lds + wave * LRU_WAVE_LDS, (const bf16*)(ws + WS_PROJ), (bf16*)(ws + WS_MIX), (const f32x2*)(ws + WS_SUMM), (const unsigned*)(ws + WS_AB), b, j, n, lane);
#endif
            }
        }
        SPLIT_SEAM(pb + 2, 4 + 6 * l, 1 + 4 * l);
        if (IN(pb + 3)) {
            unsigned char* ws = p.ws; LAUNDER(ws);
            pg8::Gemm g{(const bf16*)(ws + WS_MIX), (const bf16*)(ws + WS_W + (size_t)l * W_LAYER + W_OUT_OFF), M, DM, DM}; pg8::StaticOrder S; S.init(M, DM, G, (int)blockIdx.x);
            if (RESID_LO && l == 0) { pg8::EpiResid<true, false, RESID_LO> E{I.x, nullptr, nullptr, nullptr, (bf16*)(ws + WS_XB), (bf16*)(ws + WS_LO1), (float*)(ws + WS_SSQB), 1.0f};
                pg8::gemm_phase<pg8::EpiResid<true, false, RESID_LO>, pg8::StaticOrder, false, true>(lds, g, S, E); }
            else { pg8::EpiResid<false, false, RESID_LO> E{nullptr, (const bf16*)(ws + WS_XB), (const bf16*)p.out  , nullptr, (bf16*)(ws + WS_XB), (bf16*)(ws + WS_LO1), (float*)(ws + WS_SSQB), 1.0f};
                pg8::gemm_phase<pg8::EpiResid<false, false, RESID_LO>, pg8::StaticOrder, false, true>(lds, g, S, E); }
        }
        SPLIT_SEAM(pb + 3, 5 + 6 * l, 2 + 4 * l);
        if (IN(pb + 4)) {
            unsigned char* ws = p.ws; LAUNDER(ws);
            pg8::Gemm g{(const bf16*)(ws + WS_XB), (const bf16*)(ws + WS_W + (size_t)l * W_LAYER + W_UP_OFF), M, FF, DM}; pg8::StaticOrder S; S.init(M, FF, G, (int)blockIdx.x);
            pg8::EpiScaleBf16<1> E{(bf16*)(ws + WS_H), FF, (const float*)(ws + WS_SSQB)};
            for (int rep = 0; rep < REP_G3; ++rep) pg8::gemm_phase<pg8::EpiScaleBf16<1>, pg8::StaticOrder, true, true>(lds, g, S, E);
        }
        SPLIT_SEAM(pb + 4, 6 + 6 * l, 3 + 4 * l);
        if (IN(pb + 5)) {
            unsigned char* ws = p.ws; LAUNDER(ws);
            pg8::Gemm g{(const bf16*)(ws + WS_H), (const bf16*)(ws + WS_W + (size_t)l * W_LAYER + W_DOWN_OFF), M, DM, FF}; pg8::StaticOrder S; S.init(M, DM, G, (int)blockIdx.x);
            if (l + 1 < DEPTH) { pg8::EpiResid<false, false, RESID_LO> E{nullptr, (const bf16*)(ws + WS_XB), (const bf16*)(ws + WS_LO1), nullptr, (bf16*)(ws + WS_XB), (bf16*)p.out  , (float*)(ws + WS_SSQA), 1.0f};
                pg8::gemm_phase<pg8::EpiResid<false, false, RESID_LO>, pg8::StaticOrder, false, true>(lds, g, S, E); }
            else { pg8::EpiResid<false, true, RESID_LO> E{nullptr, (const bf16*)(ws + WS_XB), (const bf16*)(ws + WS_LO1), p.out, nullptr, nullptr, nullptr, 1.0f};
                pg8::gemm_phase<pg8::EpiResid<false, true, RESID_LO>, pg8::StaticOrder, false, true>(lds, g, S, E); }
        }
        if (l + 1 < DEPTH) SPLIT_SEAM(pb + 5, 7 + 6 * l, 4 + 4 * l);
    }
#undef SPLIT_SEAM
#undef IN
#undef SEAM
}

#ifndef MK_N_LAUNCHES
#define MK_N_LAUNCHES 1
#endif
extern "C" void kernel_launch(void* const* d_in, const int* in_sizes, int n_in, void* d_out, int out_size, void* d_ws, size_t ws_size, hipStream_t stream) {
    static int grid = 0;
    if (grid == 0) {
        if (n_in != 16 || out_size != M * DM || ws_size < WS_END) { fprintf(stderr, "kernel_launch: unexpected shapes (n_in %d out %d ws %zu)\n", n_in, out_size, ws_size); grid = -1; return; }
        int dev = 0, cus = 0, per_cu = 0;
        (void)hipGetDevice(&dev); (void)hipDeviceGetAttribute(&cus, hipDeviceAttributeMultiprocessorCount, dev);
        if (hipFuncSetAttribute((const void*)fwd_megakernel, hipFuncAttributeMaxDynamicSharedMemorySize, LDS_BYTES) != hipSuccess) { fprintf(stderr, "kernel_launch: hipFuncSetAttribute failed\n"); grid = -1; return; }
        if (hipOccupancyMaxActiveBlocksPerMultiprocessor(&per_cu, (const void*)fwd_megakernel, NWAVES * 64, LDS_BYTES) != hipSuccess || per_cu < 1) { fprintf(stderr, "kernel_launch: occupancy query gave %d\n", per_cu); per_cu = 1; }
        (void)hipGetLastError();
        grid = cus * per_cu;
        fprintf(stderr, "kernel_launch: grid %d (cus %d x %d)\n", grid, cus, per_cu);
    }
    if (grid < 0) return;
    Params a{};
    for (int i = 0; i < 16; ++i) a.in[i] = (const float*)d_in[i];
    a.out = (float*)d_out; a.ws = (unsigned char*)d_ws;
    if (MK_N_LAUNCHES == 1) {
        a.ph_lo = 0; a.ph_hi = N_PHASES;
        if (hipMemsetAsync((unsigned char*)d_ws + WS_BAR, 0, 2 * XCD_BAR_WORDS * sizeof(unsigned), stream) != hipSuccess) { fprintf(stderr, "kernel_launch: hipMemsetAsync of the barrier words failed\n"); return; }
        void* args[] = {&a};
        hipError_t e = hipLaunchCooperativeKernel((const void*)fwd_megakernel, dim3(grid), dim3(NWAVES * 64), args, LDS_BYTES, stream);
        if (e != hipSuccess) fprintf(stderr, "cooperative launch failed: %s (grid %d)\n", hipGetErrorString(e), grid);
    } else {
        for (int ph = 0; ph < N_PHASES; ++ph) { a.ph_lo = ph; a.ph_hi = ph + 1; hipLaunchKernelGGL(fwd_megakernel, dim3(grid), dim3(NWAVES * 64), LDS_BYTES, stream, a); }
    }
}
```
